# Optimizing an MI355X kernel written in HIP

```python
import math
import jax, jax.numpy as jnp
from jax import lax
import numpy as np

D_MODEL = 2048
BATCH = 4
SEQ = 4096
DEPTH = 2

HEAD_DIM = 128
DIL_PATTERNS = ((128, 1), (512, 4), (2048, 16))
N_DIL_GROUPS = 3
HEADS_PER_DIL_GROUP = 4
N_HEADS_A = N_DIL_GROUPS * HEADS_PER_DIL_GROUP
WIDTH_A = N_HEADS_A * HEAD_DIM
WIDTH_A_OUT = HEADS_PER_DIL_GROUP * HEAD_DIM
BAND_BLOCK = 128
N_HEADS_B = 8
WIDTH_B = N_HEADS_B * HEAD_DIM
N_IDX_HEADS = 16
IDX_DIM = 64
TOPK_MAX = 256
QUERY_BLOCK = 128
N_HEADS_TOTAL = N_HEADS_A + N_HEADS_B
REL_BUCKETS = 32
REL_MAX_DIST = 2048
D_FF = -(-8 * D_MODEL // (3 * 256)) * 256
RMS_EPS = 1e-6
PROJ_WIDTHS = (WIDTH_A, WIDTH_A, WIDTH_A, WIDTH_B, WIDTH_B, WIDTH_B,
               N_IDX_HEADS * IDX_DIM, IDX_DIM, N_IDX_HEADS, D_MODEL, D_MODEL)
D_IN = 3 * WIDTH_A + 3 * WIDTH_B + N_IDX_HEADS * IDX_DIM + IDX_DIM + N_IDX_HEADS + 2 * D_MODEL

kernel_name = "gated_dilated_dsa_hybrid"


def rms_norm(x, g):
    xf = x.astype(jnp.float32)
    y = xf * lax.rsqrt(jnp.mean(xf * xf, axis=-1, keepdims=True) + RMS_EPS)
    return (y * g.astype(jnp.float32)).astype(x.dtype)


def t5_bucket(dist):
    n = jnp.maximum(dist, 0)
    max_exact = REL_BUCKETS // 2
    nf = jnp.maximum(n, 1).astype(jnp.float32)
    large = max_exact + (jnp.log(nf / max_exact) / math.log(REL_MAX_DIST / max_exact)
                         * (REL_BUCKETS - max_exact)).astype(jnp.int32)
    large = jnp.minimum(large, REL_BUCKETS - 1)
    return jnp.where(n < max_exact, n, large)


def proj_split_points():
    pts, acc = [], 0
    for w in PROJ_WIDTHS[:-1]:
        acc += w
        pts.append(acc)
    return pts


def dilated_window_attention(q, k, v, dilation, steps, bias_table):
    B, S, H, Dh = q.shape
    span = dilation * BAND_BLOCK
    n_blk = -(-S // span)
    s_pad = n_blk * span

    def to_strided(a):
        a = jnp.pad(a, ((0, 0), (0, s_pad - S), (0, 0), (0, 0)))
        a = a.reshape(B, n_blk, BAND_BLOCK, dilation, H, Dh)
        return a.transpose(0, 3, 4, 1, 2, 5)

    def with_prev(a):
        prev = jnp.pad(a, ((0, 0), (0, 0), (0, 0), (1, 0), (0, 0), (0, 0)))[:, :, :, :-1]
        return jnp.concatenate([prev, a], axis=4)

    qs = to_strided(q)
    kb = with_prev(to_strided(k))
    vb = with_prev(to_strided(v))

    qi = jnp.arange(BAND_BLOCK)[:, None]
    kj = jnp.arange(2 * BAND_BLOCK)[None, :]
    delta = qi + BAND_BLOCK - kj
    band = (delta >= 0) & (delta <= steps)
    has_prev = (jnp.arange(n_blk) > 0)[:, None, None]
    mask = band[None] & (has_prev | (kj >= BAND_BLOCK)[None])
    bias = bias_table[t5_bucket(delta * dilation)].astype(jnp.float32).transpose(2, 0, 1)

    s = jnp.einsum('brhnqe,brhnke->brhnqk', qs, kb,
                   preferred_element_type=jnp.float32) * (Dh ** -0.5)
    s = s + bias[None, None, :, None]
    s = jnp.where(mask[None, None, None], s, -jnp.inf)
    m = jnp.max(s, axis=-1, keepdims=True)
    p = jnp.exp(s - m)
    l = jnp.sum(p, axis=-1)
    o = jnp.einsum('brhnqk,brhnke->brhnqe', p.astype(v.dtype), vb,
                   preferred_element_type=jnp.float32) / l[..., None]
    lse = m[..., 0] + jnp.log(l)
    o = o.transpose(0, 3, 4, 1, 2, 5).reshape(B, s_pad, H, Dh)[:, :S]
    lse = lse.transpose(0, 3, 4, 1, 2).reshape(B, s_pad, H)[:, :S]
    return o, lse


def dsa_attention(q, k, v, q_idx, k_idx, w_idx, bias_table):
    B, S, H, Dh = q.shape
    topk = min(TOPK_MAX, S // 4)
    nb = S // QUERY_BLOCK
    key_pos = jnp.arange(S)

    def blocks(a):
        return jnp.moveaxis(a.reshape((B, nb, QUERY_BLOCK) + a.shape[2:]), 1, 0)

    def one_block(args):
        qb, qib, wib, t0 = args
        tq = t0 + jnp.arange(QUERY_BLOCK)
        dots = jnp.einsum('bqhe,bse->bqhs', qib, k_idx,
                          preferred_element_type=jnp.float32) * (IDX_DIM ** -0.5)
        score = jnp.einsum('bqhs,bqh->bqs', jax.nn.relu(dots),
                           wib.astype(jnp.float32) * (N_IDX_HEADS ** -0.5))
        score = jnp.where(key_pos[None, None, :] <= tq[None, :, None], score, -jnp.inf)
        _, sel = lax.top_k(score, topk)
        valid = sel <= tq[None, :, None]
        kg = jax.vmap(lambda a, i: a[i])(k, sel)
        vg = jax.vmap(lambda a, i: a[i])(v, sel)
        bias = bias_table[t5_bucket(tq[None, :, None] - sel)].astype(jnp.float32)
        s = jnp.einsum('bqhe,bqkhe->bhqk', qb, kg,
                       preferred_element_type=jnp.float32) * (Dh ** -0.5)
        s = s + bias.transpose(0, 3, 1, 2)
        s = jnp.where(valid[:, None], s, -jnp.inf)
        p = jax.nn.softmax(s, axis=-1)
        return jnp.einsum('bhqk,bqkhe->bqhe', p.astype(v.dtype), vg,
                          preferred_element_type=jnp.float32)

    t0s = jnp.arange(nb, dtype=jnp.int32) * QUERY_BLOCK
    out = lax.map(one_block, (blocks(q), blocks(q_idx), blocks(w_idx), t0s))
    return jnp.moveaxis(out, 0, 1).reshape(B, S, H * Dh)


def setup_inputs(seed: int = 0) -> dict:
    key = jax.random.key(seed)
    ks = jax.random.split(key, 13)
    f32 = jnp.float32

    def nrm(k, shape, fan_in):
        return jax.random.normal(k, shape, f32) * (fan_in ** -0.5)

    return {
        "x": jax.random.normal(ks[0], (BATCH, SEQ, D_MODEL), f32),
        "w_in": nrm(ks[1], (DEPTH, D_MODEL, D_IN), D_MODEL),
        "w_out_a": nrm(ks[2], (DEPTH, WIDTH_A_OUT, D_MODEL), WIDTH_A_OUT),
        "w_out_b": nrm(ks[3], (DEPTH, WIDTH_B, D_MODEL), WIDTH_B),
        "w_out": nrm(ks[4], (DEPTH, D_MODEL, D_MODEL), D_MODEL),
        "w_ff_gate": nrm(ks[5], (DEPTH, D_MODEL, D_FF), D_MODEL),
        "w_ff_up": nrm(ks[6], (DEPTH, D_MODEL, D_FF), D_MODEL),
        "w_ff_down": nrm(ks[7], (DEPTH, D_FF, D_MODEL), D_FF),
        "g_mix": 1.0 + 0.02 * jax.random.normal(ks[8], (DEPTH, D_MODEL), f32),
        "g_ffn": 1.0 + 0.02 * jax.random.normal(ks[9], (DEPTH, D_MODEL), f32),
        "g_final": 1.0 + 0.02 * jax.random.normal(ks[10], (D_MODEL,), f32),
        "rel_bias": 0.2 * jax.random.normal(ks[11], (REL_BUCKETS, N_HEADS_TOTAL), f32),
    }


def reference(x, w_in, w_out_a, w_out_b, w_out, w_ff_gate, w_ff_up, w_ff_down,
              g_mix, g_ffn, g_final, rel_bias):
    B, S, _ = x.shape
    splits = proj_split_points()
    for layer in range(DEPTH):
        h = rms_norm(x, g_mix[layer])
        proj = h @ w_in[layer]
        qa, ka, va, qb, kb, vb, qi, ki, wi, gate_a, gate_b = jnp.split(proj, splits, axis=-1)

        grp = (B, S, N_DIL_GROUPS, HEADS_PER_DIL_GROUP, HEAD_DIM)
        qa, ka, va = qa.reshape(grp), ka.reshape(grp), va.reshape(grp)
        outs, lses = [], []
        for g, (window, dilation) in enumerate(DIL_PATTERNS):
            cols = rel_bias[:, g * HEADS_PER_DIL_GROUP:(g + 1) * HEADS_PER_DIL_GROUP]
            o, lse = dilated_window_attention(qa[:, :, g], ka[:, :, g], va[:, :, g],
                                              dilation, window // dilation, cols)
            outs.append(o)
            lses.append(lse)
        wts = jax.nn.softmax(jnp.stack(lses), axis=0)
        y_a = jnp.sum(wts[..., None] * jnp.stack(outs), axis=0)
        y_a = y_a.reshape(B, S, WIDTH_A_OUT).astype(x.dtype)

        hb = (B, S, N_HEADS_B, HEAD_DIM)
        y_b = dsa_attention(qb.reshape(hb), kb.reshape(hb), vb.reshape(hb),
                            qi.reshape(B, S, N_IDX_HEADS, IDX_DIM), ki, wi,
                            rel_bias[:, N_HEADS_A:]).astype(x.dtype)

        merged = (jax.nn.sigmoid(gate_a) * (y_a @ w_out_a[layer])
                  + jax.nn.sigmoid(gate_b) * (y_b @ w_out_b[layer]))
        x = x + merged @ w_out[layer]

        h = rms_norm(x, g_ffn[layer])
        x = x + (jax.nn.silu(h @ w_ff_gate[layer]) * (h @ w_ff_up[layer])) @ w_ff_down[layer]
    return rms_norm(x, g_final)
```

```cpp
#include <hip/hip_runtime.h>
#include <cstdio>
#include <cstdint>

#ifndef MK_PER_PHASE_LAUNCH
#define MK_PER_PHASE_LAUNCH 0
#endif

#ifndef PROBE_MASK
#define PROBE_MASK 0
#endif
#ifndef F8_DOWN_MASK
#define F8_DOWN_MASK 2
#endif
#define F8_DOWN(l) (((F8_DOWN_MASK) >> (l)) & 1)
#define PH_REP(k) _Pragma("unroll 1") for (int rep_ = 0; rep_ < 1 + ((PROBE_MASK >> (k)) & 1); ++rep_)
#define LAS __attribute__((address_space(3)))
#define GAS __attribute__((address_space(1)))
typedef _Float16 h16;
typedef _Float16 h16x8 __attribute__((ext_vector_type(8)));
typedef _Float16 h16x4 __attribute__((ext_vector_type(4)));
typedef _Float16 h16x2 __attribute__((ext_vector_type(2)));
typedef float f32x2 __attribute__((ext_vector_type(2)));
typedef float f32x4 __attribute__((ext_vector_type(4)));
typedef float f32x16 __attribute__((ext_vector_type(16)));
typedef unsigned u32x2 __attribute__((ext_vector_type(2)));
typedef unsigned u32x4 __attribute__((ext_vector_type(4)));
typedef short v4i16_t __attribute__((ext_vector_type(4)));
typedef int v4i32 __attribute__((ext_vector_type(4)));
typedef int v8i32 __attribute__((ext_vector_type(8)));
typedef GAS unsigned gu32;
template <int N> struct IC { static constexpr int value = N; };

constexpr int BATCH = 4, SEQ = 4096, DM = 2048, DEPTH = 2, M = BATCH * SEQ;
constexpr int WIDTH_A = 1536, WIDTH_B = 1024, NIDX = 16, IDXD = 64;
constexpr int DIN = 12880, NP1 = 13056;
constexpr int DFF = 5632, NGU = 2 * DFF;
constexpr int TOPK = 256;
constexpr float RMS_EPS = 1e-6f;
constexpr float LOG2E = 1.4426950408889634f;
constexpr float C2 = 0.08838834764831845f * LOG2E;

constexpr size_t MiB = 1u << 20;
constexpr size_t WS_CTL = 0, CTL_ZERO_BYTES = 32 * 1024;
constexpr size_t WS_W1 = 1 * MiB, WS_WA = 52 * MiB, WS_WB = 54 * MiB, WS_WO = 58 * MiB, WS_WGU = 66 * MiB, WS_WD = 110 * MiB;
constexpr size_t WS_H16 = 132 * MiB;
constexpr size_t WS_QA = 196 * MiB, WS_KA = 244 * MiB, WS_VA = 292 * MiB;
constexpr size_t WS_QB = 340 * MiB, WS_KB = 372 * MiB, WS_VB = 404 * MiB;
constexpr size_t WS_QI = 436 * MiB, WS_KI = 468 * MiB, WS_WI = 470 * MiB, WS_LSE = 471 * MiB;
constexpr size_t WS_GA = 472 * MiB, WS_GB = 536 * MiB;
constexpr size_t WS_X = 600 * MiB;
constexpr size_t WS_END = 776 * MiB;
constexpr int CW_BAR = 4096;

constexpr int RING_BYTES = 131072;
constexpr int LDSCTL_OFF = RING_BYTES, MISC_OFF = LDSCTL_OFF + 320;
constexpr int LDS_BYTES = 147456;
constexpr int NWAVES = 8, NTHREADS = 512;

__device__ __forceinline__ unsigned pkh(float lo, float hi) { f32x2 v = {lo, hi}; h16x2 b = __builtin_convertvector(v, h16x2); return __builtin_bit_cast(unsigned, b); }
__device__ __forceinline__ unsigned pkf8(float a, float b, float c, float d) { int w = __builtin_amdgcn_cvt_pk_fp8_f32(a, b, 0, false); w = __builtin_amdgcn_cvt_pk_fp8_f32(c, d, w, true); return (unsigned)w; }
__device__ __forceinline__ v8i32 cat8(h16x8 a, h16x8 b) { return __builtin_shufflevector(__builtin_bit_cast(v4i32, a), __builtin_bit_cast(v4i32, b), 0, 1, 2, 3, 4, 5, 6, 7); }
__device__ __forceinline__ float relu_imax(float x) { const int i = __float_as_int(x); return __int_as_float(i > 0 ? i : 0); }
#define I1_RELU(x) relu_imax(x)
__device__ __forceinline__ float sig255_(float x, float c1) { return __builtin_amdgcn_rcpf(fmaf(__builtin_amdgcn_exp2f(x * c1), 1.0f / 255.0f, 1.0f / 255.0f)); }
__device__ __forceinline__ float sigmoidf_(float x) { return __builtin_amdgcn_rcpf(1.0f + __builtin_amdgcn_exp2f(-x * LOG2E)); }
#define LDS_WAIT() asm volatile("s_waitcnt lgkmcnt(0)" ::: "memory")
#define VM_WAIT() asm volatile("s_waitcnt vmcnt(0)" ::: "memory")

namespace pg8 {
constexpr int BM = 256, BK = 64, HALF = 128, HTB = HALF * BK * 2, STAGE_BYTES = 8 * HTB, NXCD = 8, WGM = 8;
__host__ __device__ __forceinline__ int lds_byte(int r, int c) { const int st = (r >> 4) * 2 + (c >> 5), rr = r & 15, cc = c & 31, ob = rr * 64 + cc * 2; return st * 1024 + (ob ^ (((ob >> 9) & 1) << 5)); }
__host__ __device__ __forceinline__ void stage_rc(int b, int& R, int& C) { const int st = b / 1024, sb = b % 1024, swz = sb ^ (((sb >> 9) & 1) << 5); R = (st >> 1) * 16 + swz / 64; C = (st & 1) * 32 + (swz % 64) / 2; }
__host__ __device__ __forceinline__ int perm32(int rho) { const int n = rho >> 4, i = rho & 15; return 8 * (i >> 2) + 4 * n + (i & 3); }
struct Unit { int pm, pn; };
struct Gemm { const h16* A; const h16* Bt; int M, N, K; };
struct StaticOrder {
    int nM, nN, nwg, G, c;
    __host__ __device__ void init(int M_, int N_, int G_, int c_) { nM = M_ / BM; nN = N_ / BM; nwg = nM * nN; G = G_; c = c_; }
    __host__ __device__ bool next(int i, Unit& u) const {
        const long L = (long)i * G + c; if (L >= nwg) return false;
        int wgid = (int)L; { const int q = nwg / NXCD, r = nwg % NXCD, xcd = wgid % NXCD, off = wgid / NXCD; wgid = (xcd < r ? xcd * (q + 1) : r * (q + 1) + (xcd - r) * q) + off; }
        const int nig = WGM * nN, gid = wgid / nig, fm = gid * WGM, gsz = (nM - fm) < WGM ? (nM - fm) : WGM;
        u.pm = fm + ((wgid % nig) % gsz); u.pn = (wgid % nig) / gsz; return true;
    }
    __device__ __forceinline__ void a_ready(const Unit&) const {}
    __device__ __forceinline__ void done(const Unit&) const {}
};
struct IdxOrder {
    int x, cl, cpx;
    __host__ __device__ void init(int G_, int c_) { x = c_ % NXCD; cl = c_ / NXCD; cpx = G_ / NXCD; }
    __host__ __device__ bool next(int i, Unit& u) const { const int o = cl + i * cpx; if (o >= 40) return false; u.pm = 8 * x + (o & 7); u.pn = 30 + (o >> 3); return true; }
    __device__ __forceinline__ void a_ready(const Unit&) const {}
    __device__ __forceinline__ void done(const Unit&) const {}
};
struct F8Order {
    int x, cl, cpx;
    __host__ __device__ void init(int G_, int c_) { x = c_ % NXCD; cl = c_ / NXCD; cpx = G_ / NXCD; }
    __host__ __device__ bool next(int i, Unit& u) const {
        int o;
        if (cpx == 32) { if (i < 9) o = i * 32 + cl; else { if (cl < 8 || i >= 11) return false; o = 288 + (i - 9) * 24 + (cl - 8); } }
        else { o = cl + i * cpx; if (o >= 336) return false; }
        const int q = o >> 3; u.pm = 8 * x + (o & 7); u.pn = q < 26 ? q : q + 9; return true;
    }
    __device__ __forceinline__ void a_ready(const Unit&) const {}
    __device__ __forceinline__ void done(const Unit&) const {}
};
struct VtOrder {
    int x, cl, cpx;
    __host__ __device__ void init(int G_, int c_) { x = c_ % NXCD; cl = c_ / NXCD; cpx = G_ / NXCD; }
    __host__ __device__ bool next(int i, Unit& u) const { const int o = cl + i * cpx; if (o >= 32) return false; u.pm = 26 + (o >> 3); u.pn = 8 * x + (o & 7); return true; }
    __device__ __forceinline__ void a_ready(const Unit&) const {}
    __device__ __forceinline__ void done(const Unit&) const {}
};
template <class Epi, class Sched, int TMID = 0, bool F8 = false>
__device__ __forceinline__ void gemm_phase(LAS unsigned char* lds, const Gemm g, const Sched& S, const Epi& E, const int tid) {
    const int wid = __builtin_amdgcn_readfirstlane(tid >> 6), lane = tid & 63, wr = wid >> 2, wc = wid & 3, fr = lane & 15, fq = lane >> 4;
    const int K = g.K, RB = F8 ? K : 2 * K, nt = RB / 128;
    unsigned voffA[2], voffB[2];
#pragma unroll
    for (int i = 0; i < 2; ++i) { int R, C; stage_rc(tid * 16 + i * 8192, R, C); const int Rb = Epi::PERM ? ((R & ~31) + perm32(R & 31)) : R;
        voffA[i] = (unsigned)(R * RB + C * 2); voffB[i] = (unsigned)(Rb * RB + C * 2); }
    const size_t kstep = (size_t)(BK * 2);
    const size_t hstep = (size_t)HALF * RB;
    const size_t tstep = 2 * hstep;
    const unsigned ldsw = (unsigned)wid * 1024u;
    const int aoff = lds_byte(wr * 64 + fr, fq * 8); int boff = lds_byte(wc * 32 + fr, fq * 8) + 4 * HTB;
    asm volatile("" : "+v"(boff));
#define PG8_SA(b, h) (((b) * 2 + (h)) * HTB)
#define PG8_SB(b, h) ((4 + (b) * 2 + (h)) * HTB)
#define PG8_STAGE(bufoff, gbase, voff) do { if constexpr (F8) { unsigned vo_ = (voff)[0]; const char* g0_ = (const char*)(gbase); const char* g1_ = g0_ + 64 * RB; asm volatile("" : "+v"(vo_), "+s"(g0_), "+s"(g1_)); \
        __builtin_amdgcn_global_load_lds((const unsigned*)(g0_ + vo_), (LAS unsigned*)(lds + (bufoff) + ldsw), 16, 0, 0); __builtin_amdgcn_global_load_lds((const unsigned*)(g1_ + vo_), (LAS unsigned*)(lds + (bufoff) + ldsw + 8192), 16, 0, 0); } \
      else { _Pragma("unroll") for (int _i = 0; _i < 2; ++_i) \
        __builtin_amdgcn_global_load_lds((const unsigned*)((const char*)(gbase) + (voff)[_i]), (LAS unsigned*)(lds + (bufoff) + ldsw + _i * 8192), 16, 0, 0); } } while (0)
#define PG8_LDA(dst, b, h) do { _Pragma("unroll") for (int m = 0; m < 4; ++m) _Pragma("unroll") for (int k = 0; k < 2; ++k) dst[m][k] = *(const LAS h16x8*)(lds + PG8_SA(b, h) + aoff + m * 2048 + k * 1024); } while (0)
#define PG8_LDB(dst, b, h) do { _Pragma("unroll") for (int n = 0; n < 2; ++n) _Pragma("unroll") for (int k = 0; k < 2; ++k) dst[n][k] = *(const LAS h16x8*)(lds + ((b) * 2 + (h)) * HTB + boff + n * 2048 + k * 1024); } while (0)
#define PG8_MMA(ai, bj, At, Bt) do { __builtin_amdgcn_s_setprio(1); _Pragma("unroll") for (int m = 0; m < 4; ++m) _Pragma("unroll") for (int n = 0; n < 2; ++n) { \
        if constexpr (F8) acc[ai][bj][m][n] = __builtin_amdgcn_mfma_scale_f32_16x16x128_f8f6f4(cat8(Bt[n][0], Bt[n][1]), cat8(At[m][0], At[m][1]), acc[ai][bj][m][n], 0, 0, 0, 0, 0, 0); \
        else { _Pragma("unroll") for (int k = 0; k < 2; ++k) acc[ai][bj][m][n] = __builtin_amdgcn_mfma_f32_16x16x32_f16(Bt[n][k], At[m][k], acc[ai][bj][m][n], 0, 0, 0); } } \
        __builtin_amdgcn_s_setprio(0); } while (0)
#define PG8_WAIT_V(n) asm volatile("s_waitcnt vmcnt(" #n ")" ::: "memory")
#define PG8_WAIT_L(n) asm volatile("s_waitcnt lgkmcnt(" #n ")" ::: "memory")
#define PG8_BAR __builtin_amdgcn_s_barrier()
#define PG8_SCHED __builtin_amdgcn_sched_barrier(0)
    Unit cur, nxt; int ui = 0;
    if (!S.next(0, cur)) return;
    f32x4 acc[2][2][4][2];
#pragma unroll
    for (int a = 0; a < 2; ++a)
#pragma unroll
        for (int b = 0; b < 2; ++b)
#pragma unroll
            for (int m = 0; m < 4; ++m)
#pragma unroll
                for (int n = 0; n < 2; ++n) acc[a][b][m][n] = (f32x4){0.f, 0.f, 0.f, 0.f};
    h16x8 At[4][2], B0[2][2], B1[2][2];
    const char* cA = (const char*)g.A + (size_t)cur.pm * tstep; const char* cB = (const char*)g.Bt + (size_t)cur.pn * tstep;
    S.a_ready(cur);
    PG8_STAGE(PG8_SB(0, 0), cB, voffB); PG8_STAGE(PG8_SB(0, 1), cB + hstep, voffB); PG8_STAGE(PG8_SA(0, 0), cA, voffA); PG8_STAGE(PG8_SA(0, 1), cA + hstep, voffA);
    if (wr == 1) PG8_BAR;
    PG8_WAIT_V(2); PG8_BAR;
    PG8_STAGE(PG8_SB(1, 0), cB + kstep, voffB); PG8_STAGE(PG8_SA(1, 0), cA + kstep, voffA); PG8_STAGE(PG8_SB(1, 1), cB + hstep + kstep, voffB);
    PG8_WAIT_V(6); PG8_BAR;
    for (;;) {
        const bool has_next = S.next(ui + 1, nxt);
        const char* nA = has_next ? (const char*)g.A + (size_t)nxt.pm * tstep : cA; const char* nB = has_next ? (const char*)g.Bt + (size_t)nxt.pn * tstep : cB;
        for (int t = 0; t < nt; t += 2) {
            const bool last = (t == nt - 2);
            const char* a1 = cA + (size_t)(t + 1) * kstep;
            const char* a2 = last ? nA : cA + (size_t)(t + 2) * kstep; const char* b2 = last ? nB : cB + (size_t)(t + 2) * kstep;
            const char* a3 = a2 + kstep; const char* b3 = b2 + kstep;
            if (last && has_next) S.a_ready(nxt);
            if constexpr (TMID != 0) { if (t == TMID) { E.mid(acc, cur, wr, wc, fr, fq); PG8_SCHED; } }
            PG8_LDB(B0, 0, 0); PG8_LDB(B1, 0, 1); PG8_SCHED; PG8_LDA(At, 0, 0); PG8_STAGE(PG8_SA(1, 1), a1 + hstep, voffA);
            PG8_WAIT_V(8); PG8_WAIT_L(0); PG8_BAR; PG8_MMA(0, 0, At, B0); PG8_MMA(0, 1, At, B1); PG8_BAR; PG8_SCHED;
            PG8_LDA(At, 0, 1); PG8_STAGE(PG8_SB(0, 0), b2, voffB); PG8_STAGE(PG8_SB(0, 1), b2 + hstep, voffB); PG8_STAGE(PG8_SA(0, 0), a2, voffA);
            PG8_WAIT_V(8); PG8_WAIT_L(0); PG8_BAR; PG8_MMA(1, 0, At, B0); PG8_MMA(1, 1, At, B1); PG8_BAR; PG8_SCHED;
            PG8_LDB(B0, 1, 0); PG8_LDB(B1, 1, 1); PG8_SCHED; PG8_LDA(At, 1, 0); PG8_STAGE(PG8_SA(0, 1), a2 + hstep, voffA);
            PG8_WAIT_V(8); PG8_WAIT_L(0); PG8_BAR; PG8_MMA(0, 0, At, B0); PG8_MMA(0, 1, At, B1); PG8_BAR; PG8_SCHED;
            PG8_LDA(At, 1, 1); PG8_STAGE(PG8_SB(1, 0), b3, voffB); PG8_STAGE(PG8_SB(1, 1), b3 + hstep, voffB); PG8_STAGE(PG8_SA(1, 0), a3, voffA);
            PG8_WAIT_V(8); PG8_WAIT_L(0); PG8_BAR; PG8_MMA(1, 0, At, B0); PG8_MMA(1, 1, At, B1); PG8_BAR; PG8_SCHED;
        }
        if (wr == 0) PG8_BAR;
        E(acc, cur, wr, wc, fr, fq); S.done(cur);
        if (!has_next) break;
#pragma unroll
        for (int a = 0; a < 2; ++a)
#pragma unroll
            for (int b = 0; b < 2; ++b)
#pragma unroll
                for (int m = 0; m < 4; ++m)
#pragma unroll
                    for (int n = 0; n < 2; ++n) acc[a][b][m][n] = (f32x4){0.f, 0.f, 0.f, 0.f};
        cur = nxt; cA = nA; cB = nB; ++ui;
        if (wr == 1) PG8_BAR;
    }
    PG8_WAIT_V(0);
    PG8_BAR;
#undef PG8_SA
#undef PG8_SB
#undef PG8_STAGE
#undef PG8_LDA
#undef PG8_LDB
#undef PG8_MMA
#undef PG8_WAIT_V
#undef PG8_WAIT_L
#undef PG8_BAR
#undef PG8_SCHED
}

__device__ __forceinline__ u32x4 pack8h(f32x4 a, f32x4 b) { u32x4 w; w.x = pkh(a[0], a[1]); w.y = pkh(a[2], a[3]); w.z = pkh(b[0], b[1]); w.w = pkh(b[2], b[3]); return w; }
__device__ __forceinline__ void unpack8h(u32x4 w, f32x4& a, f32x4& b) {
    const h16x8 h = __builtin_bit_cast(h16x8, w);
    a = (f32x4){(float)h[0], (float)h[1], (float)h[2], (float)h[3]}; b = (f32x4){(float)h[4], (float)h[5], (float)h[6], (float)h[7]};
}
struct EpiProj {
    static constexpr bool PERM = true;
    h16 *QA, *QB, *QI, *KI; unsigned char* G8; float* WI; float osc;
    __device__ __forceinline__ void operator()(const f32x4 (&acc)[2][2][4][2], const Unit& u, int wr, int wc, int fr, int fq) const {
        { int z_ = 0; asm volatile("" : "+v"(z_)); const int ln_ = (int)__builtin_amdgcn_mbcnt_hi(~0u, __builtin_amdgcn_mbcnt_lo(~0u, (unsigned)z_)); fr = ln_ & 15; fq = ln_ >> 4; }
        const int pn = u.pn; const int row0 = u.pm * BM + wr * 64 + fr, colw = wc * 32 + 8 * fq;
        if (pn == 34) {
#pragma unroll
            for (int ai = 0; ai < 2; ++ai)
#pragma unroll
                for (int m = 0; m < 4; ++m) { const size_t row = (size_t)(row0 + ai * HALF + m * 16);
                    if (wc < 2) *(u32x4*)(KI + row * 64 + colw) = pack8h(acc[ai][0][m][0] * osc, acc[ai][0][m][1] * osc);
                    else if (wc == 2 && fq < 2) { *(f32x4*)(WI + row * 16 + 8 * fq) = acc[ai][0][m][0] * osc; *(f32x4*)(WI + row * 16 + 8 * fq + 4) = acc[ai][0][m][1] * osc; } }
            return;
        }
        if (pn >= 18 && pn < 26) {
            const int q = pn - 18, s = q >> 2; unsigned char* b8 = (unsigned char*)(QB + (size_t)s * M * WIDTH_B) + (q - 4 * s) * BM + colw;
#pragma unroll
            for (int ai = 0; ai < 2; ++ai)
#pragma unroll
                for (int m = 0; m < 4; ++m) { unsigned char* rowp = b8 + (size_t)(row0 + ai * HALF + m * 16) * WIDTH_B;
#pragma unroll
                    for (int bj = 0; bj < 2; ++bj) { const f32x4 v0 = acc[ai][bj][m][0] * osc, v1 = acc[ai][bj][m][1] * osc;
                        *(u32x2*)(rowp + bj * HALF) = (u32x2){pkf8(v0[0], v0[1], v0[2], v0[3]), pkf8(v1[0], v1[1], v1[2], v1[3])}; } }
            return; }
        if (pn < 12) {
            const int s = pn / 6; unsigned char* b8 = (unsigned char*)(QA + (size_t)s * M * WIDTH_A) + (pn - 6 * s) * BM + colw;
#pragma unroll
            for (int ai = 0; ai < 2; ++ai)
#pragma unroll
                for (int m = 0; m < 4; ++m) { unsigned char* rowp = b8 + (size_t)(row0 + ai * HALF + m * 16) * WIDTH_A;
#pragma unroll
                    for (int bj = 0; bj < 2; ++bj) { const f32x4 v0 = acc[ai][bj][m][0] * osc, v1 = acc[ai][bj][m][1] * osc;
                        *(u32x2*)(rowp + bj * HALF) = (u32x2){pkf8(v0[0], v0[1], v0[2], v0[3]), pkf8(v1[0], v1[1], v1[2], v1[3])}; } }
            return; }
        h16* base; int ldc, colt; bool sig = false;
        if (pn < 18) { const int s = pn / 6; base = QA + (size_t)s * M * WIDTH_A; ldc = WIDTH_A; colt = (pn - 6 * s) * BM; }
        else if (pn < 30) { const int q = pn - 18, s = q / 4; base = QB + (size_t)s * M * WIDTH_B; ldc = WIDTH_B; colt = (q - 4 * s) * BM; }
        else if (pn < 34) { base = QI; ldc = 1024; colt = (pn - 30) * BM; }
        else {
            const int q = pn - 35, s8 = q / 8; unsigned char* gb_ = G8 + (size_t)s8 * M * DM + (q - 8 * s8) * BM + colw;
            const float c1_ = -osc * LOG2E;
#pragma unroll
            for (int ai = 0; ai < 2; ++ai)
#pragma unroll
                for (int m = 0; m < 4; ++m) { unsigned char* rowp = gb_ + (size_t)(row0 + ai * HALF + m * 16) * DM;
#pragma unroll
                    for (int bj = 0; bj < 2; ++bj) { u32x2 w = {0u, 0u};
#pragma unroll
                        for (int e = 0; e < 4; ++e) { w.x = __builtin_amdgcn_cvt_pk_u8_f32(sig255_(acc[ai][bj][m][0][e], c1_), e, w.x); w.y = __builtin_amdgcn_cvt_pk_u8_f32(sig255_(acc[ai][bj][m][1][e], c1_), e, w.y); }
                        *(u32x2*)(rowp + bj * HALF) = w; } }
            return; }
#pragma unroll
        for (int ai = 0; ai < 2; ++ai)
#pragma unroll
            for (int m = 0; m < 4; ++m) { h16* rowp = base + (size_t)(row0 + ai * HALF + m * 16) * ldc + colt + colw;
#pragma unroll
                for (int bj = 0; bj < 2; ++bj) { f32x4 v0 = acc[ai][bj][m][0] * osc, v1 = acc[ai][bj][m][1] * osc;
                    if (sig) {
#pragma unroll
                        for (int e = 0; e < 4; ++e) { v0[e] = sigmoidf_(v0[e]); v1[e] = sigmoidf_(v1[e]); } }
                    *(u32x4*)(rowp + bj * HALF) = pack8h(v0, v1); } }
    }
};
struct EpiVT {
    static constexpr bool PERM = true;
    unsigned char* VT; float osc;
    __device__ __forceinline__ void operator()(const f32x4 (&acc)[2][2][4][2], const Unit& u, int wr, int wc, int fr, int fq) const {
        { int z_ = 0; asm volatile("" : "+v"(z_)); const int ln_ = (int)__builtin_amdgcn_mbcnt_hi(~0u, __builtin_amdgcn_mbcnt_lo(~0u, (unsigned)z_)); fr = ln_ & 15; fq = ln_ >> 4; }
        const int wt = u.pm - 26, tokt = u.pn, b = tokt >> 4;
#pragma unroll
        for (int ai = 0; ai < 2; ++ai) { const int bh = b * 8 + 2 * wt + ai;
#pragma unroll
            for (int m = 0; m < 4; ++m) { const int d = 64 * wr + 16 * m + fr;
#pragma unroll
                for (int bj = 0; bj < 2; ++bj) { const int t64 = 4 * (tokt & 15) + 2 * bj + (wc >> 1);
                    unsigned char* q = VT + ((size_t)((bh * 64 + t64) * 128 + d) * 64 + 16 * (wc & 1) + 4 * fq);
#pragma unroll
                    for (int n = 0; n < 2; ++n) { const f32x4 v = acc[ai][bj][m][n] * osc; *(unsigned*)(q + 32 * n) = pkf8(v[0], v[1], v[2], v[3]); } } } }
    }
};
struct EpiMerge {
    static constexpr bool PERM = true;
    const unsigned char* Ga; const unsigned char* Gb; unsigned char* Out;
    static __device__ __forceinline__ void unpk(u32x2 q, f32x4& g0, f32x4& g1) { const unsigned a_ = q.x, b_ = q.y;
        g0 = (f32x4){(float)(a_ & 0xffu), (float)((a_ >> 8) & 0xffu), (float)((a_ >> 16) & 0xffu), (float)(a_ >> 24)};
        g1 = (f32x4){(float)(b_ & 0xffu), (float)((b_ >> 8) & 0xffu), (float)((b_ >> 16) & 0xffu), (float)(b_ >> 24)}; }
    __device__ __forceinline__ void mid(f32x4 (&acc)[2][2][4][2], const Unit& u, int wr, int wc, int fr, int fq) const {
        int row0 = u.pm * BM + wr * 64 + fr, col0 = u.pn * BM + wc * 32 + 8 * fq;
        asm volatile("" : "+v"(row0), "+v"(col0));
#pragma unroll
        for (int ai = 0; ai < 2; ++ai) {
            u32x2 qa[4][2], qb[4][2];
#pragma unroll
            for (int m = 0; m < 4; ++m) { const size_t off = (size_t)(row0 + ai * HALF + m * 16) * DM + col0;
#pragma unroll
                for (int bj = 0; bj < 2; ++bj) { qa[m][bj] = *(const u32x2*)(Ga + off + bj * HALF); qb[m][bj] = *(const u32x2*)(Gb + off + bj * HALF); } }
#pragma unroll
            for (int m = 0; m < 4; ++m)
#pragma unroll
                for (int bj = 0; bj < 2; ++bj) { f32x4 a0, a1, b0, b1; unpk(qa[m][bj], a0, a1); unpk(qb[m][bj], b0, b1);
#pragma unroll
                    for (int e = 0; e < 4; ++e) { acc[ai][bj][m][0][e] *= a0[e] * __builtin_amdgcn_rcpf(fmaxf(b0[e], 0.5f)); acc[ai][bj][m][1][e] *= a1[e] * __builtin_amdgcn_rcpf(fmaxf(b1[e], 0.5f)); } }
            asm volatile("" ::: "memory"); }
    }
    __device__ __forceinline__ void operator()(const f32x4 (&acc)[2][2][4][2], const Unit& u, int wr, int wc, int fr, int fq) const {
        int row0 = u.pm * BM + wr * 64 + fr, col0 = u.pn * BM + wc * 32 + 8 * fq;
        asm volatile("" : "+v"(row0), "+v"(col0));
#pragma unroll
        for (int ai = 0; ai < 2; ++ai) {
            u32x2 qb[4][2];
#pragma unroll
            for (int m = 0; m < 4; ++m) { const size_t off = (size_t)(row0 + ai * HALF + m * 16) * DM + col0;
#pragma unroll
                for (int bj = 0; bj < 2; ++bj) qb[m][bj] = *(const u32x2*)(Gb + off + bj * HALF); }
#pragma unroll
            for (int m = 0; m < 4; ++m) { const size_t off = (size_t)(row0 + ai * HALF + m * 16) * DM + col0;
#pragma unroll
                for (int bj = 0; bj < 2; ++bj) { f32x4 b0, b1; unpk(qb[m][bj], b0, b1); f32x4 v0, v1;
#pragma unroll
                    for (int e = 0; e < 4; ++e) { v0[e] = acc[ai][bj][m][0][e] * (fmaxf(b0[e], 0.5f) * (1.0f / (255.0f * 32.0f))); v1[e] = acc[ai][bj][m][1][e] * (fmaxf(b1[e], 0.5f) * (1.0f / (255.0f * 32.0f))); }
                    *(u32x2*)(Out + off + bj * HALF) = (u32x2){pkf8(v0[0], v0[1], v0[2], v0[3]), pkf8(v1[0], v1[1], v1[2], v1[3])}; } }
            asm volatile("" ::: "memory"); }
    }
};
struct EpiResid {
    static constexpr bool PERM = true;
    const h16* base; h16* out; float osc;
    __device__ __forceinline__ void operator()(const f32x4 (&acc)[2][2][4][2], const Unit& u, int wr, int wc, int fr, int fq) const {
        const int row0 = u.pm * BM + wr * 64 + fr, col0 = u.pn * BM + wc * 32 + 8 * fq;
#pragma unroll
        for (int ai = 0; ai < 2; ++ai) {
            u32x4 bq[4][2];
#pragma unroll
            for (int m = 0; m < 4; ++m) { const size_t off = (size_t)(row0 + ai * HALF + m * 16) * DM + col0;
#pragma unroll
                for (int bj = 0; bj < 2; ++bj) bq[m][bj] = *(const u32x4*)(base + off + bj * HALF); }
#pragma unroll
            for (int m = 0; m < 4; ++m) { const size_t off = (size_t)(row0 + ai * HALF + m * 16) * DM + col0;
#pragma unroll
                for (int bj = 0; bj < 2; ++bj) { f32x4 b0, b1; unpack8h(bq[m][bj], b0, b1);
                    *(u32x4*)(out + off + bj * HALF) = pack8h(b0 + acc[ai][bj][m][0] * osc, b1 + acc[ai][bj][m][1] * osc); } }
            asm volatile("" ::: "memory"); }
    }
};
template <bool O8>
struct EpiSwiglu {
    static constexpr bool PERM = true;
    h16* HID;
    __device__ __forceinline__ void operator()(const f32x4 (&acc)[2][2][4][2], const Unit& u, int wr, int wc, int fr, int fq) const {
        const int row0 = u.pm * BM + wr * 64 + fr, col0 = u.pn * HALF + wc * 32 + 8 * fq;
#pragma unroll
        for (int ai = 0; ai < 2; ++ai)
#pragma unroll
            for (int m = 0; m < 4; ++m) { f32x4 o[2];
#pragma unroll
                for (int n = 0; n < 2; ++n)
#pragma unroll
                    for (int e = 0; e < 4; ++e) { const float gt = acc[ai][0][m][n][e], up = acc[ai][1][m][n][e]; o[n][e] = (gt * up) * __builtin_amdgcn_rcpf(1.0f + __builtin_amdgcn_exp2f(-gt)); }
                if (O8) *(u32x2*)((unsigned char*)HID + (size_t)(row0 + ai * HALF + m * 16) * DFF + col0) = (u32x2){pkf8(o[0][0] * 4.f, o[0][1] * 4.f, o[0][2] * 4.f, o[0][3] * 4.f), pkf8(o[1][0] * 4.f, o[1][1] * 4.f, o[1][2] * 4.f, o[1][3] * 4.f)};
                else __builtin_nontemporal_store(pack8h(o[0], o[1]), (u32x4*)(HID + (size_t)(row0 + ai * HALF + m * 16) * DFF + col0)); }
    }
};
}

#define XB_TMO      128
#define XB_XCNT(j)  (256  + 64 * (j))
#define XB_XSUB(j)  (1280 + 64 * (j))
#define XB_XGEN(j)  (2304 + 64 * (j))
#define XB_TOP      3328
#define XB_TOPGEN   3392
#define XCD_BAR_WORDS 3456
#define XB_SPIN_CAP (1u << 18)
static_assert((CW_BAR + XCD_BAR_WORDS) * 4 <= (int)CTL_ZERO_BYTES, "barrier words inside the per-call memset");
__device__ __forceinline__ unsigned xb_ld(unsigned* p)              { return __hip_atomic_load(p, __ATOMIC_RELAXED, __HIP_MEMORY_SCOPE_AGENT); }
__device__ __forceinline__ unsigned xb_add(unsigned* p, unsigned v) { return __hip_atomic_fetch_add(p, v, __ATOMIC_RELAXED, __HIP_MEMORY_SCOPE_AGENT); }
__device__ __forceinline__ unsigned xb_xcc_id() { return (unsigned)__builtin_amdgcn_s_getreg((3 << 11) | 20) & 0xFu; }
#define XB_SPIN(cond, bar) do { unsigned _sp = 0; while (cond) { __builtin_amdgcn_s_sleep(1); \
    if ((++_sp & 255u) == 0u) { if (xb_ld(&(bar)[XB_TMO])) break; if (_sp > XB_SPIN_CAP) { atomicAdd(&(bar)[XB_TMO], 1u); break; } } } } while (0)
struct XcdBarrier { unsigned* bar; unsigned x; volatile LAS unsigned* st; };
__device__ __forceinline__ XcdBarrier xcd_barrier_post(unsigned* bar, volatile LAS unsigned* st) {
    XcdBarrier b; b.bar = bar; b.x = xb_xcc_id(); b.st = st;
    if (threadIdx.x == 0) (void)xb_add(&bar[XB_XCNT(b.x)], 1u);
    return b;
}
__device__ __forceinline__ void xcd_barrier_complete(unsigned* bar, unsigned x, unsigned& nloc, unsigned& nx) {
    const unsigned G = gridDim.x * gridDim.y * gridDim.z;
    unsigned sum, cnt, mine, sp = 0u;
    for (;;) {
        sum = 0u; cnt = 0u; mine = 0u;
#pragma unroll 1
        for (unsigned j = 0; j < 16; ++j) { const unsigned c = xb_ld(&bar[XB_XCNT(j)]); sum += c; cnt += (c > 0u) ? 1u : 0u; mine = (j == x) ? c : mine; }
        if (sum == G) break;
        __builtin_amdgcn_s_sleep(1);
        if ((++sp & 255u) == 0u) { if (xb_ld(&bar[XB_TMO])) break; if (sp > XB_SPIN_CAP) { atomicAdd(&bar[XB_TMO], 1u); break; } }
    }
    nloc = mine > 0u ? mine : 1u; nx = cnt > 0u ? cnt : 1u;
}
__device__ __forceinline__ void xcd_barrier(const XcdBarrier& b) {
    asm volatile("s_waitcnt vmcnt(0)" ::: "memory");
    __syncthreads();
    if (threadIdx.x == 0) {
        unsigned* bar = b.bar;
        __builtin_amdgcn_s_waitcnt(0);
        unsigned nloc = b.st[0], nx = b.st[1];
        if (nloc == 0u) { xcd_barrier_complete(bar, b.x, nloc, nx); b.st[0] = nloc; b.st[1] = nx; }
        const unsigned old = xb_add(&bar[XB_XSUB(b.x)], 1u);
        const unsigned gen = old / nloc;
        if (old + 1u == (gen + 1u) * nloc) {
            __builtin_amdgcn_fence(__ATOMIC_RELEASE, "agent");
            asm volatile("s_waitcnt vmcnt(0)" ::: "memory");
            const unsigned og = xb_add(&bar[XB_TOP], 1u);
            const unsigned tg = og / nx;
            if (og + 1u == (tg + 1u) * nx) xb_add(&bar[XB_TOPGEN], 1u);
            else XB_SPIN(xb_ld(&bar[XB_TOPGEN]) == tg, bar);
            __builtin_amdgcn_fence(__ATOMIC_ACQUIRE, "agent");
            xb_add(&bar[XB_XGEN(b.x)], 1u);
            asm volatile("s_waitcnt vmcnt(0)" ::: "memory");
        } else {
            XB_SPIN(xb_ld(&bar[XB_XGEN(b.x)]) == gen, bar);
            __builtin_amdgcn_fence(__ATOMIC_ACQUIRE, "agent");
            asm volatile("s_waitcnt vmcnt(0)" ::: "memory");
        }
    }
    __syncthreads();
}

__device__ __forceinline__ float wave_sum(float v) {
#define WS_DPP(x, ctrl) __builtin_bit_cast(float, __builtin_amdgcn_update_dpp(0, __builtin_bit_cast(int, (x)), (ctrl), 0xf, 0xf, false))
    v += WS_DPP(v, 0xB1); v += WS_DPP(v, 0x4E); v += WS_DPP(v, 0x141); v += WS_DPP(v, 0x140);
#undef WS_DPP
    const int iv = __builtin_bit_cast(int, v);
    return (__builtin_bit_cast(float, __builtin_amdgcn_readlane(iv, 0)) + __builtin_bit_cast(float, __builtin_amdgcn_readlane(iv, 16)))
         + (__builtin_bit_cast(float, __builtin_amdgcn_readlane(iv, 32)) + __builtin_bit_cast(float, __builtin_amdgcn_readlane(iv, 48)));
}
__device__ __forceinline__ int wave_sum_i(int v) {
#pragma unroll
    for (int o = 1; o < 64; o <<= 1) v += __shfl_xor(v, o);
    return v;
}
__device__ __forceinline__ int wave_sum_dpp(int v) {
    v += __builtin_amdgcn_update_dpp(0, v, 0xB1, 0xf, 0xf, false);
    v += __builtin_amdgcn_update_dpp(0, v, 0x4E, 0xf, 0xf, false);
    v += __builtin_amdgcn_update_dpp(0, v, 0x141, 0xf, 0xf, false);
    v += __builtin_amdgcn_update_dpp(0, v, 0x140, 0xf, 0xf, false);
    return __builtin_amdgcn_readlane(v, 0) + __builtin_amdgcn_readlane(v, 16) + __builtin_amdgcn_readlane(v, 32) + __builtin_amdgcn_readlane(v, 48);
}
template <bool F8>
__device__ __forceinline__ void rms_rows_h16(const h16* __restrict__ x, const float* __restrict__ g, h16* __restrict__ out, unsigned char* __restrict__ out8, int gw, int NGW, int lane) {
    f32x4 ga[4], gb[4];
#pragma unroll
    for (int j = 0; j < 4; ++j) { ga[j] = *(const f32x4*)(g + 8 * (lane + 64 * j)); gb[j] = *(const f32x4*)(g + 8 * (lane + 64 * j) + 4); }
    for (int m0 = gw; m0 < M; m0 += 2 * NGW) {
        const int m1 = (m0 + NGW < M) ? m0 + NGW : m0;
        u32x4 r0[4], r1[4];
#pragma unroll
        for (int j = 0; j < 4; ++j) { r0[j] = *((const u32x4*)(x + (size_t)m0 * DM) + lane + 64 * j); r1[j] = *((const u32x4*)(x + (size_t)m1 * DM) + lane + 64 * j); }
        f32x4 va[4], vb[4], wa[4], wb[4]; float s0 = 0.f, s1 = 0.f;
#pragma unroll
        for (int j = 0; j < 4; ++j) { pg8::unpack8h(r0[j], va[j], vb[j]); pg8::unpack8h(r1[j], wa[j], wb[j]);
            s0 += (va[j].x * va[j].x + va[j].y * va[j].y) + (va[j].z * va[j].z + va[j].w * va[j].w) + (vb[j].x * vb[j].x + vb[j].y * vb[j].y) + (vb[j].z * vb[j].z + vb[j].w * vb[j].w);
            s1 += (wa[j].x * wa[j].x + wa[j].y * wa[j].y) + (wa[j].z * wa[j].z + wa[j].w * wa[j].w) + (wb[j].x * wb[j].x + wb[j].y * wb[j].y) + (wb[j].z * wb[j].z + wb[j].w * wb[j].w); }
        const float q0 = 1.0f / sqrtf(wave_sum(s0) * (1.0f / DM) + RMS_EPS), q1 = 1.0f / sqrtf(wave_sum(s1) * (1.0f / DM) + RMS_EPS);
#pragma unroll
        for (int j = 0; j < 4; ++j) { const f32x4 ya = va[j] * q0 * ga[j], yb = vb[j] * q0 * gb[j], za = wa[j] * q1 * ga[j], zb = wb[j] * q1 * gb[j];
            *((u32x4*)(out + (size_t)m0 * DM) + lane + 64 * j) = pg8::pack8h(ya, yb); *((u32x4*)(out + (size_t)m1 * DM) + lane + 64 * j) = pg8::pack8h(za, zb);
            if (F8) { *((u32x2*)(out8 + (size_t)m0 * DM) + lane + 64 * j) = (u32x2){pkf8(ya.x, ya.y, ya.z, ya.w), pkf8(yb.x, yb.y, yb.z, yb.w)};
                      *((u32x2*)(out8 + (size_t)m1 * DM) + lane + 64 * j) = (u32x2){pkf8(za.x, za.y, za.z, za.w), pkf8(zb.x, zb.y, zb.z, zb.w)}; } }
    }
}
__device__ __forceinline__ int t5_bucket(int n) {
    if (n < 16) return n < 0 ? 0 : n;
    int b = 16;
    b += (n >= 22) + (n >= 30) + (n >= 40) + (n >= 54) + (n >= 73) + (n >= 99) + (n >= 134) + (n >= 182) + (n >= 246) + (n >= 332) + (n >= 450) + (n >= 609) + (n >= 825) + (n >= 1117) + (n >= 1513);
    return b;
}
constexpr int T5_FAR = 1513;

template <int MAP> __device__ __forceinline__ int dest_row(int n) {
    if (MAP == 1) return n < 8784 ? n : n + 176;
    if (MAP == 2) return 256 * (n >> 7) + (n & 127);
    if (MAP == 3) return 256 * (n >> 7) + 128 + (n & 127);
    return n;
}
template <int MAP, int OUT8 = 0>
__device__ __forceinline__ void transpose_item(const float* __restrict__ W, int K, int N, h16* __restrict__ WT, LAS float* scr, int item, int lane, int dpitch = 0, int dkoff = 0, unsigned char* __restrict__ WT8 = nullptr, float sc8 = 64.f) {
    if (dpitch == 0) dpitch = K;
    const int nblk = (N + 31) / 32, kb = item / nblk, nb = item - kb * nblk, k0 = 64 * kb, n0 = 32 * nb;
    const int nc = n0 + (lane & 31); const bool okc = nc < N;
    float wv_[32];
#pragma unroll
    for (int i = 0; i < 32; ++i) { const int kk = 2 * i + (lane >> 5); wv_[i] = okc ? W[(size_t)(k0 + kk) * N + nc] : 0.f; }
#pragma unroll
    for (int i = 0; i < 32; ++i) { const int kk = 2 * i + (lane >> 5); scr[kk * 33 + (lane & 31)] = wv_[i]; }
    LDS_WAIT(); asm volatile("" ::: "memory");
    if (MAP == 1 || OUT8) {
        const int c4 = lane & 3;
#pragma unroll
        for (int j = 0; j < 2; ++j) { const int n = (lane >> 2) + 16 * j; const LAS float* s = scr + (16 * c4) * 33 + n;
            u32x4 o; o.x = pkf8(s[0 * 33] * sc8, s[1 * 33] * sc8, s[2 * 33] * sc8, s[3 * 33] * sc8); o.y = pkf8(s[4 * 33] * sc8, s[5 * 33] * sc8, s[6 * 33] * sc8, s[7 * 33] * sc8);
            o.z = pkf8(s[8 * 33] * sc8, s[9 * 33] * sc8, s[10 * 33] * sc8, s[11 * 33] * sc8); o.w = pkf8(s[12 * 33] * sc8, s[13 * 33] * sc8, s[14 * 33] * sc8, s[15 * 33] * sc8);
            if (n0 + n < N) *(u32x4*)(WT8 + (size_t)dest_row<MAP>(n0 + n) * dpitch + dkoff + k0 + 16 * c4) = o; }
        if (OUT8 || !(n0 >= 7680 && n0 < 8784)) { LDS_WAIT(); asm volatile("" ::: "memory"); return; }
    }
    const int c = lane & 7;
#pragma unroll
    for (int j = 0; j < 4; ++j) { const int n = (lane >> 3) + 8 * j; const LAS float* s = scr + (8 * c) * 33 + n;
        const float c16 = MAP == 2 ? LOG2E : (MAP == 3 ? 1.0f / LOG2E : 1.0f);
        u32x4 o; o.x = pkh(s[0 * 33] * c16, s[1 * 33] * c16); o.y = pkh(s[2 * 33] * c16, s[3 * 33] * c16); o.z = pkh(s[4 * 33] * c16, s[5 * 33] * c16); o.w = pkh(s[6 * 33] * c16, s[7 * 33] * c16);
        if (n0 + n < N) *(u32x4*)(WT + (size_t)dest_row<MAP>(n0 + n) * dpitch + dkoff + k0 + 8 * c) = o; }
    LDS_WAIT(); asm volatile("" ::: "memory");
}

namespace att {
constexpr int KROW = 272, VROW = 320, KROW8 = 144, VROW8 = 80;
constexpr int KT_BYTES = 64 * KROW, VT_BYTES = 64 * VROW;
constexpr int OFF_K = 0, OFF_V = 2 * KT_BYTES, OFF_TAB = OFF_V + 2 * VT_BYTES;
constexpr int TABB_DMAX = 4095, TABB_N = 4096 + 128, TABA_DMAX = 255, TABA_N = 256 + 128;
static_assert(OFF_TAB + TABB_N * 4 <= RING_BYTES, "attention LDS");

struct UnitA { const h16* Q; const h16* K; const h16* V; const unsigned char* Q8; const unsigned char* K8; const unsigned char* V8; h16* O; float* lse; size_t pitch; size_t opitch; int lse_pitch; int q0; int t_lo, t_hi; };
__device__ __forceinline__ float max3_nc(float a, float b, float c) { float r; asm("v_max3_f32 %0, %1, %2, %3" : "=v"(r) : "v"(a), "v"(b), "v"(c)); return r; }
__device__ __forceinline__ float max2_nc(float a, float b) { float r; asm("v_max_f32 %0, %1, %2" : "=v"(r) : "v"(a), "v"(b)); return r; }
template <int MODE>
__device__ __forceinline__ void attn_tile(LAS unsigned char* kbuf, LAS unsigned char* vbuf, const LAS float* tab, const h16x8 (&qr)[4], f32x16 (&o)[4], float& m_run, float& l_run,
                                          const int kb_lane, const int vb_lane, const int kb0, const int tq, const int qlo, const int hi, const u32x2 mcur, const float bias_far) {
    constexpr int DMAX = MODE == 0 ? TABA_DMAX : TABB_DMAX;
        f32x16 p0, p1;
#pragma unroll
        for (int r = 0; r < 16; ++r) { p0[r] = 0.f; p1[r] = 0.f; }
        if constexpr (true) {
            const LAS unsigned char* kp = kbuf + kb_lane;
#pragma unroll
            for (int s = 0; s < 2; ++s) { const v8i32 qq = cat8(qr[2 * s], qr[2 * s + 1]);
                const v8i32 a0 = cat8(*(const LAS h16x8*)(kp + 64 * s), *(const LAS h16x8*)(kp + 64 * s + 16)), a1 = cat8(*(const LAS h16x8*)(kp + 32 * KROW8 + 64 * s), *(const LAS h16x8*)(kp + 32 * KROW8 + 64 * s + 16));
                p0 = __builtin_amdgcn_mfma_scale_f32_32x32x64_f8f6f4(a0, qq, p0, 0, 0, 0, 0, 0, 0);
                p1 = __builtin_amdgcn_mfma_scale_f32_32x32x64_f8f6f4(a1, qq, p1, 0, 0, 0, 0, 0, 0); }
        } else { const LAS unsigned char* kp = kbuf + kb_lane;
#pragma unroll
          for (int d0 = 0; d0 < 8; ++d0) { const h16x8 a0 = *(const LAS h16x8*)(kp + 32 * d0), a1 = *(const LAS h16x8*)(kp + 32 * KROW + 32 * d0);
              p0 = __builtin_amdgcn_mfma_f32_32x32x16_f16(a0, qr[d0], p0, 0, 0, 0);
              p1 = __builtin_amdgcn_mfma_f32_32x32x16_f16(a1, qr[d0], p1, 0, 0, 0); } }
        const int dq = tq - kb0 - 4 * hi;
        if (MODE == 1 && (qlo - (kb0 + 63) >= T5_FAR)) {
#pragma unroll
            for (int r = 0; r < 16; ++r) { p0[r] = fmaf(p0[r], C2, bias_far); p1[r] = fmaf(p1[r], C2, bias_far); }
        } else {
            const LAS float* tp = tab + (DMAX - dq);
#pragma unroll
            for (int r = 0; r < 16; ++r) { const int c = (r & 3) + 8 * (r >> 2); p0[r] = fmaf(p0[r], C2, tp[c]); p1[r] = fmaf(p1[r], C2, tp[c + 32]); }
        }
        const float NEG = -__builtin_inff();
        if (MODE == 0) {
#pragma unroll
            for (int r = 0; r < 16; ++r) { const int c = (r & 3) + 8 * (r >> 2);
                if ((unsigned)(dq - c) > 128u) p0[r] = NEG;
                if ((unsigned)(dq - c - 32) > 128u) p1[r] = NEG; }
        }
        float pmax;
        {
            float a_[11], b_[4];
#pragma unroll
            for (int g = 0; g < 5; ++g) { a_[2 * g] = max3_nc(p0[3 * g], p0[3 * g + 1], p0[3 * g + 2]); a_[2 * g + 1] = max3_nc(p1[3 * g], p1[3 * g + 1], p1[3 * g + 2]); }
            a_[10] = max2_nc(p0[15], p1[15]);
            b_[0] = max3_nc(a_[0], a_[1], a_[2]); b_[1] = max3_nc(a_[3], a_[4], a_[5]); b_[2] = max3_nc(a_[6], a_[7], a_[8]); b_[3] = max2_nc(a_[9], a_[10]);
            pmax = max2_nc(max2_nc(b_[0], b_[1]), max2_nc(b_[2], b_[3])); }
        { auto rr = __builtin_amdgcn_permlane32_swap(__float_as_uint(pmax), __float_as_uint(pmax), false, false);
          pmax = fmaxf(__uint_as_float(rr[0]), __uint_as_float(rr[1])); }
        float mn = m_run, alpha = 1.f;
        if (!__all(pmax - m_run <= 8.f)) {
            mn = fmaxf(m_run, pmax); alpha = __builtin_amdgcn_exp2f(m_run - mn); m_run = mn;
#pragma unroll
            for (int d = 0; d < 4; ++d)
#pragma unroll
                for (int r = 0; r < 16; ++r) o[d][r] *= alpha;
        }
#pragma unroll
        for (int r = 0; r < 16; r += 2) { const f32x2 mn2 = {mn, mn};
            const f32x2 t0 = (f32x2){p0[r], p0[r + 1]} - mn2, t1 = (f32x2){p1[r], p1[r + 1]} - mn2;
            p0[r] = __builtin_amdgcn_exp2f(t0.x); p0[r + 1] = __builtin_amdgcn_exp2f(t0.y); p1[r] = __builtin_amdgcn_exp2f(t1.x); p1[r + 1] = __builtin_amdgcn_exp2f(t1.y); }
        if (MODE == 1) {
            const unsigned m0 = mcur.x >> (4 * hi), m1 = mcur.y >> (4 * hi);
#pragma unroll
            for (int r = 0; r < 16; ++r) { const int c = (r & 3) + 8 * (r >> 2);
                int s0_, s1_; asm("v_bfe_i32 %0, %1, %2, 1" : "=v"(s0_) : "v"(m0), "n"(c)); asm("v_bfe_i32 %0, %1, %2, 1" : "=v"(s1_) : "v"(m1), "n"(c));
                p0[r] = __uint_as_float(__float_as_uint(p0[r]) & (unsigned)s0_);
                p1[r] = __uint_as_float(__float_as_uint(p1[r]) & (unsigned)s1_); }
        }
        float ps;
        { f32x2 a_[8];
#pragma unroll
          for (int r = 0; r < 8; ++r) a_[r] = (f32x2){p0[2 * r], p0[2 * r + 1]} + (f32x2){p1[2 * r], p1[2 * r + 1]};
#pragma unroll
          for (int w_ = 4; w_ >= 1; w_ >>= 1)
#pragma unroll
              for (int r = 0; r < w_; ++r) a_[r] += a_[r + w_];
          ps = a_[0].x + a_[0].y; }
        { auto rr = __builtin_amdgcn_permlane32_swap(__float_as_uint(ps), __float_as_uint(ps), false, false);
          ps = __uint_as_float(rr[0]) + __uint_as_float(rr[1]); }
        l_run = l_run * alpha + ps;
        if constexpr (MODE == 1) {
            v8i32 pb;
            pb[0] = (int)pkf8(p0[0], p0[1], p0[2], p0[3]); pb[1] = (int)pkf8(p0[4], p0[5], p0[6], p0[7]); pb[2] = (int)pkf8(p0[8], p0[9], p0[10], p0[11]); pb[3] = (int)pkf8(p0[12], p0[13], p0[14], p0[15]);
            pb[4] = (int)pkf8(p1[0], p1[1], p1[2], p1[3]); pb[5] = (int)pkf8(p1[4], p1[5], p1[6], p1[7]); pb[6] = (int)pkf8(p1[8], p1[9], p1[10], p1[11]); pb[7] = (int)pkf8(p1[12], p1[13], p1[14], p1[15]);
            const LAS unsigned char* vp = vbuf + vb_lane;
#pragma unroll
            for (int d = 0; d < 4; ++d)
                o[d] = __builtin_amdgcn_mfma_scale_f32_32x32x64_f8f6f4(cat8(*(const LAS h16x8*)(vp + 32 * VROW8 * d), *(const LAS h16x8*)(vp + 32 * VROW8 * d + 16)), pb, o[d], 0, 0, 0, 0, 0, 0);
            return;
        }
        h16x8 pf[4];
        { u32x4 w;
          w.x = pkh(p0[0], p0[1]); w.y = pkh(p0[2], p0[3]); w.z = pkh(p0[4], p0[5]); w.w = pkh(p0[6], p0[7]); pf[0] = __builtin_bit_cast(h16x8, w);
          w.x = pkh(p0[8], p0[9]); w.y = pkh(p0[10], p0[11]); w.z = pkh(p0[12], p0[13]); w.w = pkh(p0[14], p0[15]); pf[1] = __builtin_bit_cast(h16x8, w);
          w.x = pkh(p1[0], p1[1]); w.y = pkh(p1[2], p1[3]); w.z = pkh(p1[4], p1[5]); w.w = pkh(p1[6], p1[7]); pf[2] = __builtin_bit_cast(h16x8, w);
          w.x = pkh(p1[8], p1[9]); w.y = pkh(p1[10], p1[11]); w.z = pkh(p1[12], p1[13]); w.w = pkh(p1[14], p1[15]); pf[3] = __builtin_bit_cast(h16x8, w); }
        { const LAS unsigned char* vp = vbuf + vb_lane;
#pragma unroll
          for (int d = 0; d < 4; ++d)
#pragma unroll
              for (int s = 0; s < 4; ++s) {
                  const v4i16_t lo = __builtin_amdgcn_ds_read_tr16_b64_v4i16((LAS v4i16_t*)(vp + (16 * s) * VROW + 64 * d));
                  const v4i16_t hh = __builtin_amdgcn_ds_read_tr16_b64_v4i16((LAS v4i16_t*)(vp + (16 * s + 8) * VROW + 64 * d));
                  typedef short s16x8 __attribute__((ext_vector_type(8)));
                  const s16x8 vv = {lo[0], lo[1], lo[2], lo[3], hh[0], hh[1], hh[2], hh[3]};
                  o[d] = __builtin_amdgcn_mfma_f32_32x32x16_f16(__builtin_bit_cast(h16x8, vv), pf[s], o[d], 0, 0, 0); } }
}
template <int MODE>
__device__ __forceinline__ void attn_unit(LAS unsigned char* lds, const UnitA& U, const unsigned long long* __restrict__ mask, float bias_far, const int tid) {
    const int wid = __builtin_amdgcn_readfirstlane(tid >> 6), lane = tid & 63, r32 = lane & 31, hi = lane >> 5;
    const int qlo = U.q0 + 32 * wid, tq = qlo + r32;
    constexpr int DMAX = MODE == 0 ? TABA_DMAX : TABB_DMAX;
    const LAS float* tab = (const LAS float*)(lds + OFF_TAB);
    h16x8 qr[4];
    const int pitch8 = MODE == 1 ? WIDTH_B : (int)U.pitch;
    if constexpr (true) { const unsigned char* qp = U.Q8 + (size_t)(32 * wid + r32) * pitch8 + 32 * hi;
#pragma unroll
      for (int s = 0; s < 2; ++s) { qr[2 * s] = *(const h16x8*)(qp + 64 * s); qr[2 * s + 1] = *(const h16x8*)(qp + 64 * s + 16); }
    } else { const h16* qp = U.Q + (size_t)(32 * wid + r32) * U.pitch + 8 * hi;
#pragma unroll
      for (int d0 = 0; d0 < 8; ++d0) qr[d0] = *(const h16x8*)(qp + 16 * d0); }
    const int sr = tid >> 4, sc = tid & 15;
    const int pitch_i = (int)U.pitch;
    const unsigned goff = (unsigned)(sr * pitch_i + sc * 8) * 2u, ghalf = (unsigned)(32 * pitch_i) * 2u;
    const size_t tstride = (size_t)(64 * pitch_i) * 2u;
    const int kws = (tid >> 3) * KROW8 + (tid & 7) * 16, vws = sr * VROW + sc * 16;
    const unsigned goff8 = (unsigned)((tid >> 3) * pitch8 + (tid & 7) * 16);
    const int vws8 = (tid >> 2) * VROW8 + (tid & 3) * 16;
    h16x8 sA0, sA1, sA2, sA3, sB0, sB1, sB2, sB3;
#define ATT_LOADS(K0, K1, V0, V1, t) do { \
        if constexpr (MODE == 1) { const char* kb__ = (const char*)U.K8 + (size_t)(t) * (64 * WIDTH_B); K0 = *(const h16x8*)(kb__ + goff8); V0 = *(const h16x8*)((const char*)U.V8 + (size_t)(t) * 8192 + (unsigned)(tid * 16)); } \
        else { const char* kb__ = (const char*)U.K8 + (size_t)(t) * (size_t)(64 * pitch8); const char* vb__ = (const char*)U.V + (size_t)(t) * tstride; K0 = *(const h16x8*)(kb__ + goff8); \
               V0 = *(const h16x8*)(vb__ + goff); V1 = *(const h16x8*)(vb__ + ghalf + goff); } } while (0)
#define ATT_LOADM(t) (*(const u32x2*)((const char*)(mask + (t)) + moff))
#define ATT_WRITES(K0, K1, V0, V1, buf) do { LAS unsigned char* kb_ = lds + OFF_K + (buf) * KT_BYTES; LAS unsigned char* vb_ = lds + OFF_V + (buf) * VT_BYTES; \
        if constexpr (MODE == 1) { *(LAS h16x8*)(kb_ + kws) = K0; *(LAS h16x8*)(vb_ + vws8) = V0; } \
        else { *(LAS h16x8*)(kb_ + kws) = K0; *(LAS h16x8*)(vb_ + vws) = V0; *(LAS h16x8*)(vb_ + vws + 32 * VROW) = V1; } } while (0)
#define ATT_ACT(t) (MODE == 0 ? ((64 * (t) <= qlo + 31) && (64 * (t) + 63 >= qlo - 128)) : (64 * (t) <= qlo + 31))
    const int T0 = U.t_lo, T1 = U.t_hi;
    float zf_ = 0.f; asm volatile("" : "+v"(zf_));
    u32x2 mwA, mwB;
    const unsigned moff = (unsigned)tq * 512u;
    ATT_LOADS(sA0, sA1, sA2, sA3, T0); if (MODE == 1) { mwA = ATT_LOADM(T0); mwB = mwA; }
    if (T0 + 1 < T1) { ATT_LOADS(sB0, sB1, sB2, sB3, T0 + 1); if (MODE == 1) mwB = ATT_LOADM(T0 + 1); }
    float m_run = -1e30f, l_run = zf_;
    f32x16 o[4];
#pragma unroll
    for (int d = 0; d < 4; ++d)
#pragma unroll
        for (int r = 0; r < 16; ++r) o[d][r] = zf_;
    const int kb_lane = r32 * KROW8 + hi * 32;
    const int vb_lane = MODE == 1 ? r32 * VROW8 + hi * 32 : (4 * hi + ((lane >> 2) & 3)) * VROW + (16 * ((lane >> 4) & 1) + 4 * (lane & 3)) * 2;
    for (int t = T0; t < T1; t += 2) {
        {   ATT_WRITES(sA0, sA1, sA2, sA3, 0);
            __syncthreads();
            const u32x2 mcur = MODE == 1 ? mwA : (u32x2){0u, 0u};
            if (t + 2 < T1) { ATT_LOADS(sA0, sA1, sA2, sA3, t + 2); if (MODE == 1) mwA = ATT_LOADM(t + 2); }
            if (ATT_ACT(t)) attn_tile<MODE>(lds + OFF_K, lds + OFF_V, tab, qr, o, m_run, l_run, kb_lane, vb_lane, 64 * t, tq, qlo, hi, mcur, bias_far); }
        if (t + 1 < T1) {
            ATT_WRITES(sB0, sB1, sB2, sB3, 1);
            __syncthreads();
            const u32x2 mcur = MODE == 1 ? mwB : (u32x2){0u, 0u};
            if (t + 3 < T1) { ATT_LOADS(sB0, sB1, sB2, sB3, t + 3); if (MODE == 1) mwB = ATT_LOADM(t + 3); }
            if (ATT_ACT(t + 1)) attn_tile<MODE>(lds + OFF_K + KT_BYTES, lds + OFF_V + VT_BYTES, tab, qr, o, m_run, l_run, kb_lane, vb_lane, 64 * (t + 1), tq, qlo, hi, mcur, bias_far); }
    }
#undef ATT_LOADS
#undef ATT_LOADM
#undef ATT_WRITES
#undef ATT_ACT
    const float inv = l_run > 0.f ? 1.0f / l_run : 0.f;
    if (MODE == 1) {
        unsigned char* op8 = (unsigned char*)U.O + (size_t)(32 * wid + r32) * U.opitch + 4 * hi; const float i16 = inv * 16.f;
#pragma unroll
        for (int d = 0; d < 4; ++d)
#pragma unroll
            for (int g4 = 0; g4 < 4; ++g4) *(unsigned*)(op8 + 32 * d + 8 * g4) = pkf8(o[d][4 * g4] * i16, o[d][4 * g4 + 1] * i16, o[d][4 * g4 + 2] * i16, o[d][4 * g4 + 3] * i16);
    } else {
    h16* op = U.O + (size_t)(32 * wid + r32) * U.opitch + 4 * hi;
#pragma unroll
    for (int d = 0; d < 4; ++d)
#pragma unroll
        for (int g4 = 0; g4 < 4; ++g4) { u32x2 w; w.x = pkh(o[d][4 * g4] * inv, o[d][4 * g4 + 1] * inv); w.y = pkh(o[d][4 * g4 + 2] * inv, o[d][4 * g4 + 3] * inv);
            *(u32x2*)(op + 32 * d + 8 * g4) = w; } }
    if (MODE == 0 && hi == 0) U.lse[(size_t)(32 * wid + r32) * U.lse_pitch] = m_run + __builtin_amdgcn_logf(l_run);
}
}

struct Args { const float* in[12]; float* out; unsigned char* ws; int ph_lo, ph_hi; };
#define AS4 __attribute__((address_space(4)))
typedef const unsigned char AS4* kaptr;
__device__ __forceinline__ kaptr get_ka() { kaptr p = (kaptr)__builtin_amdgcn_kernarg_segment_ptr(); asm volatile("" : "+s"(p)); return p; }
#define KA_IN(ka, k) (*(const float* const AS4*)((ka) + 8 * (k)))
#define KA_OUT(ka) (*(float* const AS4*)((ka) + 96))
#define KA_WS(ka) (*(unsigned char* const AS4*)((ka) + 104))
#define KA_LO(ka) (*(const int AS4*)((ka) + 112))
#define KA_HI(ka) (*(const int AS4*)((ka) + 116))

__global__ void __launch_bounds__(NTHREADS, 2) fwd_kernel(Args args) {
    extern __shared__ __attribute__((aligned(16))) unsigned char lds_raw[];
    LAS unsigned char* lds = (LAS unsigned char*)lds_raw;
    volatile LAS unsigned* MISC = (volatile LAS unsigned*)(lds + MISC_OFF);
#define WSP(T, off) ((T*)(ws + (off)))
#define W1T WSP(h16, WS_W1)
#define WAB8 WSP(unsigned char, WS_WA)
#define W1F8 WSP(unsigned char, WS_W1)
#define H8 WSP(unsigned char, WS_X)
#define WO8 WSP(unsigned char, WS_WO)
#define WGUT WSP(h16, WS_WGU)
#define WDT WSP(h16, WS_WD)
#define H16 ((h16*)KA_OUT(ka))
#define XS ((h16*)KA_OUT(ka) + (size_t)M * DM)
#define XF WSP(h16, WS_H16)
#define OA WSP(h16, WS_H16)
#define QA WSP(h16, WS_QA)
#define KA WSP(h16, WS_KA)
#define VA WSP(h16, WS_VA)
#define YY8 WSP(unsigned char, WS_QA)
#define MASK WSP(unsigned long long, WS_VA)
#define QB WSP(h16, WS_QB)
#define KB WSP(h16, WS_KB)
#define VB WSP(h16, WS_VB)
#define VT8 WSP(unsigned char, WS_VB)
#define QI WSP(h16, WS_QI)
#define KI WSP(h16, WS_KI)
#define WI WSP(float, WS_WI)
#define LSE WSP(float, WS_LSE)
#define GA WSP(unsigned char, WS_GA)
#define GB (WSP(unsigned char, WS_GA) + (size_t)M * DM)
#define SC WSP(unsigned short, WS_X)
#define MG8 WSP(unsigned char, WS_X)
#define HID WSP(h16, WS_X)
#define FRESH_TID(name) int name; { int zt_ = 0; asm volatile("" : "+v"(zt_)); name = wave_s * 64 + (int)__builtin_amdgcn_mbcnt_hi(~0u, __builtin_amdgcn_mbcnt_lo(~0u, (unsigned)zt_)); asm volatile("" : "+v"(name)); }
#define PH_ENTER() const kaptr ka = get_ka(); unsigned char* const ws = KA_WS(ka); (void)ws; \
    int z_ = 0; asm volatile("" : "+v"(z_)); int tid = wave_s * 64 + (int)__builtin_amdgcn_mbcnt_hi(~0u, __builtin_amdgcn_mbcnt_lo(~0u, (unsigned)z_)); asm volatile("" : "+v"(tid)); int bx = blockIdx.x; asm volatile("" : "+s"(bx)); int G = gridDim.x; asm volatile("" : "+s"(G)); \
    const int lane = tid & 63, wave = __builtin_amdgcn_readfirstlane(tid >> 6), gw = bx * NWAVES + wave, NGW = G * NWAVES; (void)lane; (void)gw; (void)NGW
    for (int u = threadIdx.x; u < (LDS_BYTES - LDSCTL_OFF) / 4; u += NTHREADS) ((LAS unsigned*)(lds + LDSCTL_OFF))[u] = 0u;
    const int wave_s = __builtin_amdgcn_readfirstlane(threadIdx.x >> 6);
    __syncthreads();
    XcdBarrier bar; int lo, hi_ph;
    { const kaptr ka = get_ka(); unsigned* ctl = (unsigned*)(KA_WS(ka) + WS_CTL); lo = KA_LO(ka); hi_ph = KA_HI(ka);
      bar.bar = ctl + CW_BAR; bar.x = 0; bar.st = nullptr;
      if (!MK_PER_PHASE_LAUNCH) bar = xcd_barrier_post(ctl + CW_BAR, MISC + 8); }
#define IN(k) (lo <= (k) && (k) < hi_ph)
#define SEAM(k) do { if (!MK_PER_PHASE_LAUNCH && IN(k) && IN((k) + 1)) xcd_barrier(bar); } while (0)

    { constexpr int layer = 0;
        const int P = layer * 10;
        if (IN(P + 0)) PH_REP(0) {
            PH_ENTER();
            const float* w_in = KA_IN(ka, 1) + (size_t)layer * DM * DIN;
            const float* w_oa = KA_IN(ka, 2) + (size_t)layer * 512 * DM;
            const float* w_ob = KA_IN(ka, 3) + (size_t)layer * 1024 * DM;
            const float* w_o = KA_IN(ka, 4) + (size_t)layer * DM * DM;
            const float* w_fg = KA_IN(ka, 5) + (size_t)layer * DM * DFF;
            const float* w_fu = KA_IN(ka, 6) + (size_t)layer * DM * DFF;
            const float* w_fd = KA_IN(ka, 7) + (size_t)layer * DFF * DM;
            const float* g_mix = KA_IN(ka, 8) + (size_t)layer * DM;
            const float* xcur = KA_IN(ka, 0);
            LAS float* scr = (LAS float*)(lds + wave * 16384);
            constexpr int I1_ = (DM / 64) * ((DIN + 31) / 32), IG = (DM / 64) * (DFF / 32), ID = (DFF / 64) * (DM / 32), IA = (512 / 64) * (DM / 32), IB = (1024 / 64) * (DM / 32), IO = (DM / 64) * (DM / 32);
            constexpr int NITEMS = I1_ + 2 * IG + ID + IA + IB + IO;
            for (int it = gw; it < NITEMS; it += NGW) {
                int r = it;
                if (r < I1_) { transpose_item<1>(w_in, DM, DIN, W1T, scr, r, lane, 0, 0, W1F8); continue; } r -= I1_;
                if (r < IG) { transpose_item<2>(w_fg, DM, DFF, WGUT, scr, r, lane); continue; } r -= IG;
                if (r < IG) { transpose_item<3>(w_fu, DM, DFF, WGUT, scr, r, lane); continue; } r -= IG;
                if (r < ID) { if (F8_DOWN(layer)) transpose_item<0, 1>(w_fd, DFF, DM, nullptr, scr, r, lane, 0, 0, (unsigned char*)WDT, 128.f); else transpose_item<0>(w_fd, DFF, DM, WDT, scr, r, lane); continue; } r -= ID;
                if (r < IA) { transpose_item<0, 1>(w_oa, 512, DM, nullptr, scr, r, lane, 1536, 0, WAB8, 32.f); continue; } r -= IA;
                if (r < IB) { transpose_item<0, 1>(w_ob, 1024, DM, nullptr, scr, r, lane, 1536, 512, WAB8, 32.f); continue; } r -= IB;
                transpose_item<0, 1>(w_o, DM, DM, nullptr, scr, r, lane, 0, 0, WO8, 64.f);
            }
            { u32x4* z = (u32x4*)(W1T + (size_t)8784 * DM); const int nz = 176 * DM * 2 / 16;
              for (int i = bx * NTHREADS + tid; i < nz; i += G * NTHREADS) z[i] = (u32x4){0u, 0u, 0u, 0u}; }
            if (layer == 0) {
                f32x4 gv[8];
#pragma unroll
                for (int j = 0; j < 8; ++j) gv[j] = *((const f32x4*)g_mix + lane + 64 * j);
                for (int m = gw; m < M; m += NGW) {
                    const f32x4* xr = (const f32x4*)(xcur + (size_t)m * DM) + lane; f32x4 v[8]; float s = 0.f;
#pragma unroll
                    for (int j = 0; j < 8; ++j) { v[j] = xr[64 * j]; s += (v[j].x * v[j].x + v[j].y * v[j].y) + (v[j].z * v[j].z + v[j].w * v[j].w); }
                    const float rs = 1.0f / sqrtf(wave_sum(s) * (1.0f / DM) + RMS_EPS);
                    u32x2* o8 = (u32x2*)(H16 + (size_t)m * DM) + lane; u32x2* x8 = (u32x2*)(XS + (size_t)m * DM) + lane;
#pragma unroll
                    for (int j = 0; j < 8; ++j) { const f32x4 y = v[j] * rs * gv[j]; u32x2 w; w.x = pkh(y.x, y.y); w.y = pkh(y.z, y.w); o8[64 * j] = w;
                        ((unsigned*)(H8 + (size_t)m * DM))[lane + 64 * j] = pkf8(y.x, y.y, y.z, y.w);
                        u32x2 xw; xw.x = pkh(v[j].x, v[j].y); xw.y = pkh(v[j].z, v[j].w); x8[64 * j] = xw; }
                }
            } else {
                rms_rows_h16<true>(XS, g_mix, H16, H8, gw, NGW, lane);
            }
        }
        SEAM(P + 0);

        if (IN(P + 1)) PH_REP(1) {
            PH_ENTER();
            const bool idx_last = (bx >> 3) & 1;
            if (!idx_last) {
                pg8::Gemm g{H16, W1T, M, NP1, DM}; pg8::IdxOrder S; S.init(G, bx);
                pg8::EpiProj E{QA, QB, QI, KI, GA, WI, 1.0f};
                pg8::gemm_phase<pg8::EpiProj, pg8::IdxOrder, 0, false>(lds, g, S, E, tid); }
            { pg8::Gemm g{(const h16*)H8, (const h16*)W1F8, M, NP1, DM}; pg8::F8Order S; S.init(G, bx);
              pg8::EpiProj E{QA, QB, QI, KI, GA, WI, 1.0f / 64.0f};
              FRESH_TID(tid2); pg8::gemm_phase<pg8::EpiProj, pg8::F8Order, 0, true>(lds, g, S, E, tid2); }
            { pg8::Gemm g{(const h16*)W1F8, (const h16*)H8, NP1, M, DM}; pg8::VtOrder S; S.init(G, bx);
              pg8::EpiVT E{VT8, 1.0f / 64.0f};
              FRESH_TID(tid3); pg8::gemm_phase<pg8::EpiVT, pg8::VtOrder, 0, true>(lds, g, S, E, tid3); }
            if (idx_last) {
                int bx2 = blockIdx.x; asm volatile("" : "+s"(bx2)); int G2 = gridDim.x; asm volatile("" : "+s"(G2));
                pg8::Gemm g{H16, W1T, M, NP1, DM}; pg8::IdxOrder S; S.init(G2, bx2);
                pg8::EpiProj E{QA, QB, QI, KI, GA, WI, 1.0f};
                FRESH_TID(tid4); pg8::gemm_phase<pg8::EpiProj, pg8::IdxOrder, 0, false>(lds, g, S, E, tid4); }
        }
        SEAM(P + 1);

        if (IN(P + 2)) PH_REP(2) {
            PH_ENTER();
            const float* rel_bias = KA_IN(ka, 11);
            PH_REP(10) for (int u0 = bx; u0 < 768; u0 += G) {
                const int u = (u0 & 7) * 96 + (u0 >> 3);
                const int b = u / 192, rem = u - b * 192, g = rem >> 6, rem2 = rem & 63, hh = rem2 >> 4, xx = rem2 & 15;
                const int dil = g == 0 ? 1 : (g == 1 ? 4 : 16), nblk = 16 / dil, res = xx / nblk, blk = xx - res * nblk;
                __syncthreads();
                { LAS float* tabw = (LAS float*)(lds + att::OFF_TAB);
                  for (int i = tid; i < att::TABA_N; i += NTHREADS) { const int dist = att::TABA_DMAX - i;
                      tabw[i] = (dist >= 0 && dist <= 128) ? rel_bias[t5_bucket(dist * dil) * 20 + g * 4 + hh] * LOG2E : 0.f; } }
                att::UnitA U; const size_t base = ((size_t)b * SEQ + res) * WIDTH_A + g * 512 + hh * 128;
                U.pitch = (size_t)dil * WIDTH_A; U.opitch = U.pitch; U.q0 = 256 * blk;
                U.K = nullptr; U.Q = nullptr; U.K8 = (const unsigned char*)KA + base; U.Q8 = (const unsigned char*)QA + base + (size_t)U.q0 * U.pitch; U.V = VA + base; U.O = OA + base + (size_t)U.q0 * U.pitch;
                U.lse = LSE + ((size_t)b * SEQ + res + (size_t)U.q0 * dil) * 12 + g * 4 + hh; U.lse_pitch = dil * 12;
                U.t_lo = blk == 0 ? 0 : 4 * blk - 2; U.t_hi = 4 * blk + 4;
                att::attn_unit<0>(lds, U, nullptr, 0.f, tid);
            }
            __syncthreads();
            {
                LAS float* wT = (LAS float*)lds;
                auto i1_item = [&](auto tln_c, const int u, const int qs, const int kh, const int tl0) {
                    constexpr int TLN = decltype(tln_c)::value;
                    int tid_u = tid; asm volatile("" : "+v"(tid_u));
                    const int lane_u = tid_u & 63, r32 = lane_u & 31, hi = lane_u >> 5;
                    const int b = u / 272; int rem = u - b * 272, i = 0;
                    { int p = 0; for (;;) { const int c = (i >> 1) + 1; if (rem < p + c) break; p += c; ++i; } rem -= p; }
                    const int j = rem;
                    __syncthreads();
                    for (int e = tid_u; e < 2048; e += NTHREADS) { const int row = e >> 4, h = e & 15; wT[h * 128 + row] = WI[((size_t)b * SEQ + 128 * i + row) * 16 + h] * 0.03125f; }
                    { const h16* kg = KI + ((size_t)b * SEQ + 256 * j) * 64;
#pragma unroll
                      for (int e4 = 0; e4 < 4; ++e4) { const int e = tid_u + NTHREADS * e4, key = e >> 3, ch = e & 7;
                          *(LAS h16x8*)(lds + 8192 + key * 144 + ch * 16) = *(const h16x8*)(kg + (size_t)key * 64 + ch * 8); } }
                    __syncthreads();
                    if (2 * j + kh <= i) {
                    const size_t tok0 = (size_t)b * SEQ + 128 * i + 32 * qs;
                    const LAS unsigned char* kl = lds + 8192 + (128 * kh + 32 * tl0 + r32) * 144 + hi * 16;
                    f32x16 acc[TLN];
                    const char* qbase = (const char*)(QI + tok0 * 1024); const unsigned qoff = (unsigned)(r32 * 1024 + 8 * hi) * 2u;
                    h16x8 afA[4], afB[4];
                    h16x8 kf[TLN][4];
#pragma unroll
                    for (int tl = 0; tl < TLN; ++tl)
#pragma unroll
                        for (int ks = 0; ks < 4; ++ks) kf[tl][ks] = *(const LAS h16x8*)(kl + (32 * tl) * 144 + 32 * ks);
#define I1_LOAD(dst, h_) do { unsigned vo_ = qoff; const char* qb_ = qbase + (size_t)(128 * (h_)); asm volatile("" : "+v"(vo_), "+s"(qb_)); \
                        _Pragma("unroll") for (int ks = 0; ks < 4; ++ks) dst[ks] = *(const h16x8*)(qb_ + vo_ + 32 * ks); } while (0)
#define I1_HEAD(af, h_, FIRST) do { f32x4 wv[4]; \
                        _Pragma("unroll") for (int g4 = 0; g4 < 4; ++g4) wv[g4] = *(const LAS f32x4*)(wT + (h_) * 128 + 32 * qs + 8 * g4 + 4 * hi); \
                        _Pragma("unroll") for (int tl = 0; tl < TLN; ++tl) { f32x16 d; \
                            _Pragma("unroll") for (int r = 0; r < 16; ++r) d[r] = 0.f; \
                            _Pragma("unroll") for (int ks = 0; ks < 4; ++ks) d = __builtin_amdgcn_mfma_f32_32x32x16_f16(af[ks], kf[tl][ks], d, 0, 0, 0); \
                            _Pragma("unroll") for (int r = 0; r < 16; ++r) acc[tl][r] = (FIRST) ? I1_RELU(d[r]) * wv[r >> 2][r & 3] : fmaf(I1_RELU(d[r]), wv[r >> 2][r & 3], acc[tl][r]); } __builtin_amdgcn_sched_barrier(0); } while (0)
                    I1_LOAD(afA, 0);
                    I1_LOAD(afB, 1);
                    I1_HEAD(afA, 0, true);
                    I1_LOAD(afA, 2);
                    I1_HEAD(afB, 1, false);
#pragma unroll 1
                    for (int h = 2; h < 16; h += 2) {
                        I1_LOAD(afB, h + 1);
                        I1_HEAD(afA, h, false);
                        if (h + 2 < 16) I1_LOAD(afA, h + 2);
                        I1_HEAD(afB, h + 1, false);
                    }
#undef I1_LOAD
#undef I1_HEAD
                    const int Li = 128 * (i + 1);
                    int zs_ = 0; asm volatile("" : "+v"(zs_)); const int lane_s = (int)__builtin_amdgcn_mbcnt_hi(~0u, __builtin_amdgcn_mbcnt_lo(~0u, (unsigned)zs_)), r32s = lane_s & 31, his = lane_s >> 5;
                    unsigned short* sp = SC + ((size_t)b * 528 + (size_t)(i * (i + 1) / 2)) * 16384 + (size_t)(32 * qs + 4 * his) * Li + 256 * j + 128 * kh + 32 * tl0 + r32s;
#pragma unroll
                    for (int tl = 0; tl < TLN; ++tl)
#pragma unroll
                        for (int r = 0; r < 16; ++r) { const float own = acc[tl][r];
                            const float nb = __builtin_bit_cast(float, __builtin_amdgcn_update_dpp(0, __builtin_bit_cast(int, own), 0xB1, 0xf, 0xf, false));
                            if (!(r32s & 1)) *(unsigned*)(sp + (size_t)((r & 3) + 8 * (r >> 2)) * Li + 32 * tl) = pkh(own, nb); }
                    }
                };
                PH_REP(11) { const int nfull = G == 256 ? 1024 : 1088;
                    for (int u0 = bx; u0 < nfull; u0 += G) i1_item(IC<4>{}, (u0 & 7) * 136 + (u0 >> 3), wave & 3, wave >> 2, 0);
                    if (G == 256) i1_item(IC<1>{}, (bx & 7) * 136 + 128 + (bx >> 5), (bx >> 3) & 3, wave >> 2, wave & 3); }
            }
        }
        SEAM(P + 2);

        if (IN(P + 3)) PH_REP(3) {
            PH_ENTER();
            PH_REP(12) for (int it = gw; it < M; it += NGW) {
                const int b = it >> 12, t0_ = it & 4095, t = t0_ < 2048 ? t0_ : 6143 - t0_, rw = (b << 12) + t, i = t >> 7, rr = t & 127, n = t + 1, nj = (n + 63) >> 6;
                const unsigned short* row = SC + ((size_t)b * 528 + (size_t)(i * (i + 1) / 2)) * 16384 + (size_t)rr * (128 * (i + 1));
                unsigned mlo = 0u, mhi = 0u;
#define TK_PUT(j, bl) do { const bool me_ = lane == (j); mlo = me_ ? (unsigned)(bl) : mlo; mhi = me_ ? (unsigned)((bl) >> 32) : mhi; asm volatile("" : "+v"(mlo), "+v"(mhi)); } while (0)
                if (n <= TOPK) {
#pragma unroll
                    for (int j = 0; j < 4; ++j) { const unsigned long long bl = __ballot(64 * j + lane < n); TK_PUT(j, bl); }
                } else {
                    unsigned uk[64];
#pragma unroll
                    for (int j = 0; j < 64; ++j) uk[j] = 0u;
#pragma unroll
                    for (int g8 = 0; g8 < 8; ++g8) if (8 * g8 < nj) {
#pragma unroll
                        for (int jj = 0; jj < 8; ++jj) { const int k = 64 * (8 * g8 + jj) + lane; uk[8 * g8 + jj] = (unsigned)row[k < n ? k : n - 1]; } }
#pragma unroll
                    for (int g8 = 0; g8 < 8; ++g8) if (8 * g8 < nj) {
#pragma unroll
                        for (int jj = 0; jj < 8; ++jj) { const int j = 8 * g8 + jj, k = 64 * j + lane;
                            unsigned bits = uk[j]; if (bits == 0x8000u) bits = 0u;
                            const unsigned key = (bits & 0x8000u) ? (~bits & 0xffffu) : (bits | 0x8000u); uk[j] = k < n ? key : 0u; } }
                    unsigned T = 0u; bool exact = false;
                    for (int bit = 15; bit >= 0; --bit) {
                        const unsigned cand = T | (1u << bit); int cl = 0;
#pragma unroll
                        for (int g8 = 0; g8 < 8; ++g8) if (8 * g8 < nj) {
#pragma unroll
                            for (int jj = 0; jj < 8; ++jj) cl += (uk[8 * g8 + jj] >= cand) ? 1 : 0; }
                        const int c = wave_sum_dpp(cl);
                        if (c >= TOPK) { T = cand; if (c == TOPK) { exact = true; break; } }
                    }
                    if (exact) {
#pragma unroll
                        for (int g8 = 0; g8 < 8; ++g8) if (8 * g8 < nj) {
#pragma unroll
                            for (int jj = 0; jj < 8; ++jj) { const unsigned long long bs = __ballot(uk[8 * g8 + jj] >= T); TK_PUT(8 * g8 + jj, bs); } }
                    } else {
                        int cgl = 0;
#pragma unroll
                        for (int g8 = 0; g8 < 8; ++g8) if (8 * g8 < nj) {
#pragma unroll
                            for (int jj = 0; jj < 8; ++jj) cgl += (uk[8 * g8 + jj] > T) ? 1 : 0; }
                        const int need = TOPK - wave_sum_dpp(cgl); int tb = 0;
#pragma unroll
                        for (int g8 = 0; g8 < 8; ++g8) if (8 * g8 < nj) {
#pragma unroll
                            for (int jj = 0; jj < 8; ++jj) { const int j = 8 * g8 + jj;
                                const bool eq = uk[j] == T; const unsigned long long be = __ballot(eq);
                                const int rank = tb + __builtin_amdgcn_mbcnt_hi((unsigned)(be >> 32), __builtin_amdgcn_mbcnt_lo((unsigned)be, 0u));
                                const bool sel = (uk[j] > T) || (eq && rank < need);
                                const unsigned long long bs = __ballot(sel); TK_PUT(j, bs);
                                tb += __popcll(be); } }
                    }
                }
#undef TK_PUT
                *(u32x2*)(MASK + (size_t)rw * 64 + lane) = (u32x2){mlo, mhi};
            }
            PH_REP(13) for (int rw0 = gw; rw0 < M; rw0 += 2 * NGW) {
                const int hh = lane >> 4, dd = (lane & 15) * 8;
                int rws[2]; rws[0] = rw0; rws[1] = (rw0 + NGW < M) ? rw0 + NGW : rw0;
                float lq[2][3]; u32x4 oq[2][3];
#pragma unroll
                for (int q = 0; q < 2; ++q) { const float* lp = LSE + (size_t)rws[q] * 12 + hh; lq[q][0] = lp[0]; lq[q][1] = lp[4]; lq[q][2] = lp[8];
                    const h16* op = OA + (size_t)rws[q] * WIDTH_A + hh * 128 + dd; oq[q][0] = *(const u32x4*)(op); oq[q][1] = *(const u32x4*)(op + 512); oq[q][2] = *(const u32x4*)(op + 1024); }
#pragma unroll
                for (int q = 0; q < 2; ++q) {
                    const float mx = fmaxf(lq[q][0], fmaxf(lq[q][1], lq[q][2]));
                    float w0 = __builtin_amdgcn_exp2f(lq[q][0] - mx), w1 = __builtin_amdgcn_exp2f(lq[q][1] - mx), w2 = __builtin_amdgcn_exp2f(lq[q][2] - mx);
                    const float inv = 1.0f / (w0 + w1 + w2); w0 *= inv; w1 *= inv; w2 *= inv;
                    f32x4 a0, a1, b0, b1, c0, c1;
                    pg8::unpack8h(oq[q][0], a0, a1); pg8::unpack8h(oq[q][1], b0, b1); pg8::unpack8h(oq[q][2], c0, c1);
                    const f32x4 y0 = a0 * w0 + b0 * w1 + c0 * w2, y1 = a1 * w0 + b1 * w1 + c1 * w2;
                    *(u32x2*)(YY8 + (size_t)rws[q] * 1536 + hh * 128 + dd) = (u32x2){pkf8(y0.x * 16.f, y0.y * 16.f, y0.z * 16.f, y0.w * 16.f), pkf8(y1.x * 16.f, y1.y * 16.f, y1.z * 16.f, y1.w * 16.f)};
                }
            }
        }
        SEAM(P + 3);

        if (IN(P + 4)) PH_REP(4) {
            PH_ENTER();
            const float* rel_bias = KA_IN(ka, 11);
            for (int pu = bx; pu < 256; pu += G) {
                const int xcd_ = pu & 7, slot_ = pu >> 3, bh = 8 * (slot_ >> 3) + xcd_, pr = slot_ & 7, b = bh >> 3, h = bh & 7;
                for (int pass = 0; pass < 2; ++pass) {
                    const int qb = pass == 0 ? 15 - pr : pr;
                    __syncthreads();
                    { LAS float* tabw = (LAS float*)(lds + att::OFF_TAB);
                      for (int i = tid; i < att::TABB_N; i += NTHREADS) { const int dist = att::TABB_DMAX - i;
                          tabw[i] = dist >= 0 ? rel_bias[t5_bucket(dist) * 20 + 12 + h] * LOG2E : 0.f; } }
                    att::UnitA U; const size_t base = (size_t)b * SEQ * WIDTH_B + h * 128;
                    U.pitch = WIDTH_B; U.opitch = 1536; U.q0 = 256 * qb;
                    U.K = nullptr; U.Q = nullptr; U.K8 = (const unsigned char*)KB + base; U.Q8 = (const unsigned char*)QB + base + (size_t)U.q0 * WIDTH_B; U.V = nullptr; U.V8 = VT8 + (size_t)(b * 8 + h) * (64 * 8192); U.O = (h16*)(YY8 + ((size_t)b * SEQ + U.q0) * 1536 + 512 + h * 128);
                    U.lse = nullptr; U.lse_pitch = 0; U.t_lo = 0; U.t_hi = 4 * qb + 4;
                    att::attn_unit<1>(lds, U, MASK + (size_t)b * SEQ * 64, rel_bias[31 * 20 + 12 + h] * LOG2E, tid);
                }
            }
            __syncthreads();
        }
        SEAM(P + 4);

        if (IN(P + 5)) PH_REP(5) {
            PH_ENTER();
            pg8::Gemm g{(const h16*)YY8, (const h16*)WAB8, M, DM, 1536}; pg8::StaticOrder S; S.init(M, DM, G, bx); pg8::EpiMerge E{GA, GB, MG8};
            pg8::gemm_phase<pg8::EpiMerge, pg8::StaticOrder, 4, true>(lds, g, S, E, tid);
        }
        SEAM(P + 5);

        if (IN(P + 6)) PH_REP(6) {
            PH_ENTER();
            pg8::Gemm g{(const h16*)MG8, (const h16*)WO8, M, DM, DM}; pg8::StaticOrder S; S.init(M, DM, G, bx); pg8::EpiResid E{XS, XS, 1.0f / 1024.0f};
            pg8::gemm_phase<pg8::EpiResid, pg8::StaticOrder, 0, true>(lds, g, S, E, tid);
        }
        SEAM(P + 6);

        if (IN(P + 7)) PH_REP(7) {
            PH_ENTER();
            const float* g_ffn = KA_IN(ka, 9) + (size_t)layer * DM;
            rms_rows_h16<false>(XS, g_ffn, H16, nullptr, gw, NGW, lane);
        }
        SEAM(P + 7);

        if (IN(P + 8)) PH_REP(8) {
            PH_ENTER();
            pg8::Gemm g{H16, WGUT, M, NGU, DM}; pg8::StaticOrder S; S.init(M, NGU, G, bx); pg8::EpiSwiglu<F8_DOWN(layer)> E{HID};
            pg8::gemm_phase<pg8::EpiSwiglu<F8_DOWN(layer)>, pg8::StaticOrder>(lds, g, S, E, tid);
        }
        SEAM(P + 8);

        if (IN(P + 9)) PH_REP(9) {
            PH_ENTER();
            pg8::Gemm g{HID, WDT, M, DM, DFF}; pg8::StaticOrder S; S.init(M, DM, G, bx); pg8::EpiResid E{XS, layer + 1 < DEPTH ? XS : XF, F8_DOWN(layer) ? 1.0f / 512.0f : 1.0f};
            pg8::gemm_phase<pg8::EpiResid, pg8::StaticOrder, 0, F8_DOWN(layer)>(lds, g, S, E, tid);
        }
        SEAM(P + 9);
        }
    { constexpr int layer = 1;
        const int P = layer * 10;
        if (IN(P + 0)) PH_REP(0) {
            PH_ENTER();
            const float* w_in = KA_IN(ka, 1) + (size_t)layer * DM * DIN;
            const float* w_oa = KA_IN(ka, 2) + (size_t)layer * 512 * DM;
            const float* w_ob = KA_IN(ka, 3) + (size_t)layer * 1024 * DM;
            const float* w_o = KA_IN(ka, 4) + (size_t)layer * DM * DM;
            const float* w_fg = KA_IN(ka, 5) + (size_t)layer * DM * DFF;
            const float* w_fu = KA_IN(ka, 6) + (size_t)layer * DM * DFF;
            const float* w_fd = KA_IN(ka, 7) + (size_t)layer * DFF * DM;
            const float* g_mix = KA_IN(ka, 8) + (size_t)layer * DM;
            const float* xcur = KA_IN(ka, 0);
            LAS float* scr = (LAS float*)(lds + wave * 16384);
            constexpr int I1_ = (DM / 64) * ((DIN + 31) / 32), IG = (DM / 64) * (DFF / 32), ID = (DFF / 64) * (DM / 32), IA = (512 / 64) * (DM / 32), IB = (1024 / 64) * (DM / 32), IO = (DM / 64) * (DM / 32);
            constexpr int NITEMS = I1_ + 2 * IG + ID + IA + IB + IO;
            for (int it = gw; it < NITEMS; it += NGW) {
                int r = it;
                if (r < I1_) { transpose_item<1>(w_in, DM, DIN, W1T, scr, r, lane, 0, 0, W1F8); continue; } r -= I1_;
                if (r < IG) { transpose_item<2>(w_fg, DM, DFF, WGUT, scr, r, lane); continue; } r -= IG;
                if (r < IG) { transpose_item<3>(w_fu, DM, DFF, WGUT, scr, r, lane); continue; } r -= IG;
                if (r < ID) { if (F8_DOWN(layer)) transpose_item<0, 1>(w_fd, DFF, DM, nullptr, scr, r, lane, 0, 0, (unsigned char*)WDT, 128.f); else transpose_item<0>(w_fd, DFF, DM, WDT, scr, r, lane); continue; } r -= ID;
                if (r < IA) { transpose_item<0, 1>(w_oa, 512, DM, nullptr, scr, r, lane, 1536, 0, WAB8, 32.f); continue; } r -= IA;
                if (r < IB) { transpose_item<0, 1>(w_ob, 1024, DM, nullptr, scr, r, lane, 1536, 512, WAB8, 32.f); continue; } r -= IB;
                transpose_item<0, 1>(w_o, DM, DM, nullptr, scr, r, lane, 0, 0, WO8, 64.f);
            }
            { u32x4* z = (u32x4*)(W1T + (size_t)8784 * DM); const int nz = 176 * DM * 2 / 16;
              for (int i = bx * NTHREADS + tid; i < nz; i += G * NTHREADS) z[i] = (u32x4){0u, 0u, 0u, 0u}; }
            if (layer == 0) {
                f32x4 gv[8];
#pragma unroll
                for (int j = 0; j < 8; ++j) gv[j] = *((const f32x4*)g_mix + lane + 64 * j);
                for (int m = gw; m < M; m += NGW) {
                    const f32x4* xr = (const f32x4*)(xcur + (size_t)m * DM) + lane; f32x4 v[8]; float s = 0.f;
#pragma unroll
                    for (int j = 0; j < 8; ++j) { v[j] = xr[64 * j]; s += (v[j].x * v[j].x + v[j].y * v[j].y) + (v[j].z * v[j].z + v[j].w * v[j].w); }
                    const float rs = 1.0f / sqrtf(wave_sum(s) * (1.0f / DM) + RMS_EPS);
                    u32x2* o8 = (u32x2*)(H16 + (size_t)m * DM) + lane; u32x2* x8 = (u32x2*)(XS + (size_t)m * DM) + lane;
#pragma unroll
                    for (int j = 0; j < 8; ++j) { const f32x4 y = v[j] * rs * gv[j]; u32x2 w; w.x = pkh(y.x, y.y); w.y = pkh(y.z, y.w); o8[64 * j] = w;
                        ((unsigned*)(H8 + (size_t)m * DM))[lane + 64 * j] = pkf8(y.x, y.y, y.z, y.w);
                        u32x2 xw; xw.x = pkh(v[j].x, v[j].y); xw.y = pkh(v[j].z, v[j].w); x8[64 * j] = xw; }
                }
            } else {
                rms_rows_h16<true>(XS, g_mix, H16, H8, gw, NGW, lane);
            }
        }
        SEAM(P + 0);

        if (IN(P + 1)) PH_REP(1) {
            PH_ENTER();
            const bool idx_last = (bx >> 3) & 1;
            if (!idx_last) {
                pg8::Gemm g{H16, W1T, M, NP1, DM}; pg8::IdxOrder S; S.init(G, bx);
                pg8::EpiProj E{QA, QB, QI, KI, GA, WI, 1.0f};
                pg8::gemm_phase<pg8::EpiProj, pg8::IdxOrder, 0, false>(lds, g, S, E, tid); }
            { pg8::Gemm g{(const h16*)H8, (const h16*)W1F8, M, NP1, DM}; pg8::F8Order S; S.init(G, bx);
              pg8::EpiProj E{QA, QB, QI, KI, GA, WI, 1.0f / 64.0f};
              FRESH_TID(tid2); pg8::gemm_phase<pg8::EpiProj, pg8::F8Order, 0, true>(lds, g, S, E, tid2); }
            { pg8::Gemm g{(const h16*)W1F8, (const h16*)H8, NP1, M, DM}; pg8::VtOrder S; S.init(G, bx);
              pg8::EpiVT E{VT8, 1.0f / 64.0f};
              FRESH_TID(tid3); pg8::gemm_phase<pg8::EpiVT, pg8::VtOrder, 0, true>(lds, g, S, E, tid3); }
            if (idx_last) {
                int bx2 = blockIdx.x; asm volatile("" : "+s"(bx2)); int G2 = gridDim.x; asm volatile("" : "+s"(G2));
                pg8::Gemm g{H16, W1T, M, NP1, DM}; pg8::IdxOrder S; S.init(G2, bx2);
                pg8::EpiProj E{QA, QB, QI, KI, GA, WI, 1.0f};
                FRESH_TID(tid4); pg8::gemm_phase<pg8::EpiProj, pg8::IdxOrder, 0, false>(lds, g, S, E, tid4); }
        }
        SEAM(P + 1);

        if (IN(P + 2)) PH_REP(2) {
            PH_ENTER();
            const float* rel_bias = KA_IN(ka, 11);
            PH_REP(10) for (int u0 = bx; u0 < 768; u0 += G) {
                const int u = (u0 & 7) * 96 + (u0 >> 3);
                const int b = u / 192, rem = u - b * 192, g = rem >> 6, rem2 = rem & 63, hh = rem2 >> 4, xx = rem2 & 15;
                const int dil = g == 0 ? 1 : (g == 1 ? 4 : 16), nblk = 16 / dil, res = xx / nblk, blk = xx - res * nblk;
                __syncthreads();
                { LAS float* tabw = (LAS float*)(lds + att::OFF_TAB);
                  for (int i = tid; i < att::TABA_N; i += NTHREADS) { const int dist = att::TABA_DMAX - i;
                      tabw[i] = (dist >= 0 && dist <= 128) ? rel_bias[t5_bucket(dist * dil) * 20 + g * 4 + hh] * LOG2E : 0.f; } }
                att::UnitA U; const size_t base = ((size_t)b * SEQ + res) * WIDTH_A + g * 512 + hh * 128;
                U.pitch = (size_t)dil * WIDTH_A; U.opitch = U.pitch; U.q0 = 256 * blk;
                U.K = nullptr; U.Q = nullptr; U.K8 = (const unsigned char*)KA + base; U.Q8 = (const unsigned char*)QA + base + (size_t)U.q0 * U.pitch; U.V = VA + base; U.O = OA + base + (size_t)U.q0 * U.pitch;
                U.lse = LSE + ((size_t)b * SEQ + res + (size_t)U.q0 * dil) * 12 + g * 4 + hh; U.lse_pitch = dil * 12;
                U.t_lo = blk == 0 ? 0 : 4 * blk - 2; U.t_hi = 4 * blk + 4;
                att::attn_unit<0>(lds, U, nullptr, 0.f, tid);
            }
            __syncthreads();
            {
                LAS float* wT = (LAS float*)lds;
                auto i1_item = [&](auto tln_c, const int u, const int qs, const int kh, const int tl0) {
                    constexpr int TLN = decltype(tln_c)::value;
                    int tid_u = tid; asm volatile("" : "+v"(tid_u));
                    const int lane_u = tid_u & 63, r32 = lane_u & 31, hi = lane_u >> 5;
                    const int b = u / 272; int rem = u - b * 272, i = 0;
                    { int p = 0; for (;;) { const int c = (i >> 1) + 1; if (rem < p + c) break; p += c; ++i; } rem -= p; }
                    const int j = rem;
                    __syncthreads();
                    for (int e = tid_u; e < 2048; e += NTHREADS) { const int row = e >> 4, h = e & 15; wT[h * 128 + row] = WI[((size_t)b * SEQ + 128 * i + row) * 16 + h] * 0.03125f; }
                    { const h16* kg = KI + ((size_t)b * SEQ + 256 * j) * 64;
#pragma unroll
                      for (int e4 = 0; e4 < 4; ++e4) { const int e = tid_u + NTHREADS * e4, key = e >> 3, ch = e & 7;
                          *(LAS h16x8*)(lds + 8192 + key * 144 + ch * 16) = *(const h16x8*)(kg + (size_t)key * 64 + ch * 8); } }
                    __syncthreads();
                    if (2 * j + kh <= i) {
                    const size_t tok0 = (size_t)b * SEQ + 128 * i + 32 * qs;
                    const LAS unsigned char* kl = lds + 8192 + (128 * kh + 32 * tl0 + r32) * 144 + hi * 16;
                    f32x16 acc[TLN];
                    const char* qbase = (const char*)(QI + tok0 * 1024); const unsigned qoff = (unsigned)(r32 * 1024 + 8 * hi) * 2u;
                    h16x8 afA[4], afB[4];
                    h16x8 kf[TLN][4];
#pragma unroll
                    for (int tl = 0; tl < TLN; ++tl)
#pragma unroll
                        for (int ks = 0; ks < 4; ++ks) kf[tl][ks] = *(const LAS h16x8*)(kl + (32 * tl) * 144 + 32 * ks);
#define I1_LOAD(dst, h_) do { unsigned vo_ = qoff; const char* qb_ = qbase + (size_t)(128 * (h_)); asm volatile("" : "+v"(vo_), "+s"(qb_)); \
                        _Pragma("unroll") for (int ks = 0; ks < 4; ++ks) dst[ks] = *(const h16x8*)(qb_ + vo_ + 32 * ks); } while (0)
#define I1_HEAD(af, h_, FIRST) do { f32x4 wv[4]; \
                        _Pragma("unroll") for (int g4 = 0; g4 < 4; ++g4) wv[g4] = *(const LAS f32x4*)(wT + (h_) * 128 + 32 * qs + 8 * g4 + 4 * hi); \
                        _Pragma("unroll") for (int tl = 0; tl < TLN; ++tl) { f32x16 d; \
                            _Pragma("unroll") for (int r = 0; r < 16; ++r) d[r] = 0.f; \
                            _Pragma("unroll") for (int ks = 0; ks < 4; ++ks) d = __builtin_amdgcn_mfma_f32_32x32x16_f16(af[ks], kf[tl][ks], d, 0, 0, 0); \
                            _Pragma("unroll") for (int r = 0; r < 16; ++r) acc[tl][r] = (FIRST) ? I1_RELU(d[r]) * wv[r >> 2][r & 3] : fmaf(I1_RELU(d[r]), wv[r >> 2][r & 3], acc[tl][r]); } __builtin_amdgcn_sched_barrier(0); } while (0)
                    I1_LOAD(afA, 0);
                    I1_LOAD(afB, 1);
                    I1_HEAD(afA, 0, true);
                    I1_LOAD(afA, 2);
                    I1_HEAD(afB, 1, false);
#pragma unroll 1
                    for (int h = 2; h < 16; h += 2) {
                        I1_LOAD(afB, h + 1);
                        I1_HEAD(afA, h, false);
                        if (h + 2 < 16) I1_LOAD(afA, h + 2);
                        I1_HEAD(afB, h + 1, false);
                    }
#undef I1_LOAD
#undef I1_HEAD
                    const int Li = 128 * (i + 1);
                    int zs_ = 0; asm volatile("" : "+v"(zs_)); const int lane_s = (int)__builtin_amdgcn_mbcnt_hi(~0u, __builtin_amdgcn_mbcnt_lo(~0u, (unsigned)zs_)), r32s = lane_s & 31, his = lane_s >> 5;
                    unsigned short* sp = SC + ((size_t)b * 528 + (size_t)(i * (i + 1) / 2)) * 16384 + (size_t)(32 * qs + 4 * his) * Li + 256 * j + 128 * kh + 32 * tl0 + r32s;
#pragma unroll
                    for (int tl = 0; tl < TLN; ++tl)
#pragma unroll
                        for (int r = 0; r < 16; ++r) { const float own = acc[tl][r];
                            const float nb = __builtin_bit_cast(float, __builtin_amdgcn_update_dpp(0, __builtin_bit_cast(int, own), 0xB1, 0xf, 0xf, false));
                            if (!(r32s & 1)) *(unsigned*)(sp + (size_t)((r & 3) + 8 * (r >> 2)) * Li + 32 * tl) = pkh(own, nb); }
                    }
                };
                PH_REP(11) { const int nfull = G == 256 ? 1024 : 1088;
                    for (int u0 = bx; u0 < nfull; u0 += G) i1_item(IC<4>{}, (u0 & 7) * 136 + (u0 >> 3), wave & 3, wave >> 2, 0);
                    if (G == 256) i1_item(IC<1>{}, (bx & 7) * 136 + 128 + (bx >> 5), (bx >> 3) & 3, wave >> 2, wave & 3); }
            }
        }
        SEAM(P + 2);

        if (IN(P + 3)) PH_REP(3) {
            PH_ENTER();
            PH_REP(12) for (int it = gw; it < M; it += NGW) {
                const int b = it >> 12, t0_ = it & 4095, t = t0_ < 2048 ? t0_ : 6143 - t0_, rw = (b << 12) + t, i = t >> 7, rr = t & 127, n = t + 1, nj = (n + 63) >> 6;
                const unsigned short* row = SC + ((size_t)b * 528 + (size_t)(i * (i + 1) / 2)) * 16384 + (size_t)rr * (128 * (i + 1));
                unsigned mlo = 0u, mhi = 0u;
#define TK_PUT(j, bl) do { const bool me_ = lane == (j); mlo = me_ ? (unsigned)(bl) : mlo; mhi = me_ ? (unsigned)((bl) >> 32) : mhi; asm volatile("" : "+v"(mlo), "+v"(mhi)); } while (0)
                if (n <= TOPK) {
#pragma unroll
                    for (int j = 0; j < 4; ++j) { const unsigned long long bl = __ballot(64 * j + lane < n); TK_PUT(j, bl); }
                } else {
                    unsigned uk[64];
#pragma unroll
                    for (int j = 0; j < 64; ++j) uk[j] = 0u;
#pragma unroll
                    for (int g8 = 0; g8 < 8; ++g8) if (8 * g8 < nj) {
#pragma unroll
                        for (int jj = 0; jj < 8; ++jj) { const int k = 64 * (8 * g8 + jj) + lane; uk[8 * g8 + jj] = (unsigned)row[k < n ? k : n - 1]; } }
#pragma unroll
                    for (int g8 = 0; g8 < 8; ++g8) if (8 * g8 < nj) {
#pragma unroll
                        for (int jj = 0; jj < 8; ++jj) { const int j = 8 * g8 + jj, k = 64 * j + lane;
                            unsigned bits = uk[j]; if (bits == 0x8000u) bits = 0u;
                            const unsigned key = (bits & 0x8000u) ? (~bits & 0xffffu) : (bits | 0x8000u); uk[j] = k < n ? key : 0u; } }
                    unsigned T = 0u; bool exact = false;
                    for (int bit = 15; bit >= 0; --bit) {
                        const unsigned cand = T | (1u << bit); int cl = 0;
#pragma unroll
                        for (int g8 = 0; g8 < 8; ++g8) if (8 * g8 < nj) {
#pragma unroll
                            for (int jj = 0; jj < 8; ++jj) cl += (uk[8 * g8 + jj] >= cand) ? 1 : 0; }
                        const int c = wave_sum_dpp(cl);
                        if (c >= TOPK) { T = cand; if (c == TOPK) { exact = true; break; } }
                    }
                    if (exact) {
#pragma unroll
                        for (int g8 = 0; g8 < 8; ++g8) if (8 * g8 < nj) {
#pragma unroll
                            for (int jj = 0; jj < 8; ++jj) { const unsigned long long bs = __ballot(uk[8 * g8 + jj] >= T); TK_PUT(8 * g8 + jj, bs); } }
                    } else {
                        int cgl = 0;
#pragma unroll
                        for (int g8 = 0; g8 < 8; ++g8) if (8 * g8 < nj) {
#pragma unroll
                            for (int jj = 0; jj < 8; ++jj) cgl += (uk[8 * g8 + jj] > T) ? 1 : 0; }
                        const int need = TOPK - wave_sum_dpp(cgl); int tb = 0;
#pragma unroll
                        for (int g8 = 0; g8 < 8; ++g8) if (8 * g8 < nj) {
#pragma unroll
                            for (int jj = 0; jj < 8; ++jj) { const int j = 8 * g8 + jj;
                                const bool eq = uk[j] == T; const unsigned long long be = __ballot(eq);
                                const int rank = tb + __builtin_amdgcn_mbcnt_hi((unsigned)(be >> 32), __builtin_amdgcn_mbcnt_lo((unsigned)be, 0u));
                                const bool sel = (uk[j] > T) || (eq && rank < need);
                                const unsigned long long bs = __ballot(sel); TK_PUT(j, bs);
                                tb += __popcll(be); } }
                    }
                }
#undef TK_PUT
                *(u32x2*)(MASK + (size_t)rw * 64 + lane) = (u32x2){mlo, mhi};
            }
            PH_REP(13) for (int rw0 = gw; rw0 < M; rw0 += 2 * NGW) {
                const int hh = lane >> 4, dd = (lane & 15) * 8;
                int rws[2]; rws[0] = rw0; rws[1] = (rw0 + NGW < M) ? rw0 + NGW : rw0;
                float lq[2][3]; u32x4 oq[2][3];
#pragma unroll
                for (int q = 0; q < 2; ++q) { const float* lp = LSE + (size_t)rws[q] * 12 + hh; lq[q][0] = lp[0]; lq[q][1] = lp[4]; lq[q][2] = lp[8];
                    const h16* op = OA + (size_t)rws[q] * WIDTH_A + hh * 128 + dd; oq[q][0] = *(const u32x4*)(op); oq[q][1] = *(const u32x4*)(op + 512); oq[q][2] = *(const u32x4*)(op + 1024); }
#pragma unroll
                for (int q = 0; q < 2; ++q) {
                    const float mx = fmaxf(lq[q][0], fmaxf(lq[q][1], lq[q][2]));
                    float w0 = __builtin_amdgcn_exp2f(lq[q][0] - mx), w1 = __builtin_amdgcn_exp2f(lq[q][1] - mx), w2 = __builtin_amdgcn_exp2f(lq[q][2] - mx);
                    const float inv = 1.0f / (w0 + w1 + w2); w0 *= inv; w1 *= inv; w2 *= inv;
                    f32x4 a0, a1, b0, b1, c0, c1;
                    pg8::unpack8h(oq[q][0], a0, a1); pg8::unpack8h(oq[q][1], b0, b1); pg8::unpack8h(oq[q][2], c0, c1);
                    const f32x4 y0 = a0 * w0 + b0 * w1 + c0 * w2, y1 = a1 * w0 + b1 * w1 + c1 * w2;
                    *(u32x2*)(YY8 + (size_t)rws[q] * 1536 + hh * 128 + dd) = (u32x2){pkf8(y0.x * 16.f, y0.y * 16.f, y0.z * 16.f, y0.w * 16.f), pkf8(y1.x * 16.f, y1.y * 16.f, y1.z * 16.f, y1.w * 16.f)};
                }
            }
        }
        SEAM(P + 3);

        if (IN(P + 4)) PH_REP(4) {
            PH_ENTER();
            const float* rel_bias = KA_IN(ka, 11);
            for (int pu = bx; pu < 256; pu += G) {
                const int xcd_ = pu & 7, slot_ = pu >> 3, bh = 8 * (slot_ >> 3) + xcd_, pr = slot_ & 7, b = bh >> 3, h = bh & 7;
                for (int pass = 0; pass < 2; ++pass) {
                    const int qb = pass == 0 ? 15 - pr : pr;
                    __syncthreads();
                    { LAS float* tabw = (LAS float*)(lds + att::OFF_TAB);
                      for (int i = tid; i < att::TABB_N; i += NTHREADS) { const int dist = att::TABB_DMAX - i;
                          tabw[i] = dist >= 0 ? rel_bias[t5_bucket(dist) * 20 + 12 + h] * LOG2E : 0.f; } }
                    att::UnitA U; const size_t base = (size_t)b * SEQ * WIDTH_B + h * 128;
                    U.pitch = WIDTH_B; U.opitch = 1536; U.q0 = 256 * qb;
                    U.K = nullptr; U.Q = nullptr; U.K8 = (const unsigned char*)KB + base; U.Q8 = (const unsigned char*)QB + base + (size_t)U.q0 * WIDTH_B; U.V = nullptr; U.V8 = VT8 + (size_t)(b * 8 + h) * (64 * 8192); U.O = (h16*)(YY8 + ((size_t)b * SEQ + U.q0) * 1536 + 512 + h * 128);
                    U.lse = nullptr; U.lse_pitch = 0; U.t_lo = 0; U.t_hi = 4 * qb + 4;
                    att::attn_unit<1>(lds, U, MASK + (size_t)b * SEQ * 64, rel_bias[31 * 20 + 12 + h] * LOG2E, tid);
                }
            }
            __syncthreads();
        }
        SEAM(P + 4);

        if (IN(P + 5)) PH_REP(5) {
            PH_ENTER();
            pg8::Gemm g{(const h16*)YY8, (const h16*)WAB8, M, DM, 1536}; pg8::StaticOrder S; S.init(M, DM, G, bx); pg8::EpiMerge E{GA, GB, MG8};
            pg8::gemm_phase<pg8::EpiMerge, pg8::StaticOrder, 4, true>(lds, g, S, E, tid);
        }
        SEAM(P + 5);

        if (IN(P + 6)) PH_REP(6) {
            PH_ENTER();
            pg8::Gemm g{(const h16*)MG8, (const h16*)WO8, M, DM, DM}; pg8::StaticOrder S; S.init(M, DM, G, bx); pg8::EpiResid E{XS, XS, 1.0f / 1024.0f};
            pg8::gemm_phase<pg8::EpiResid, pg8::StaticOrder, 0, true>(lds, g, S, E, tid);
        }
        SEAM(P + 6);

        if (IN(P + 7)) PH_REP(7) {
            PH_ENTER();
            const float* g_ffn = KA_IN(ka, 9) + (size_t)layer * DM;
            rms_rows_h16<false>(XS, g_ffn, H16, nullptr, gw, NGW, lane);
        }
        SEAM(P + 7);

        if (IN(P + 8)) PH_REP(8) {
            PH_ENTER();
            pg8::Gemm g{H16, WGUT, M, NGU, DM}; pg8::StaticOrder S; S.init(M, NGU, G, bx); pg8::EpiSwiglu<F8_DOWN(layer)> E{HID};
            pg8::gemm_phase<pg8::EpiSwiglu<F8_DOWN(layer)>, pg8::StaticOrder>(lds, g, S, E, tid);
        }
        SEAM(P + 8);

        if (IN(P + 9)) PH_REP(9) {
            PH_ENTER();
            pg8::Gemm g{HID, WDT, M, DM, DFF}; pg8::StaticOrder S; S.init(M, DM, G, bx); pg8::EpiResid E{XS, layer + 1 < DEPTH ? XS : XF, F8_DOWN(layer) ? 1.0f / 512.0f : 1.0f};
            pg8::gemm_phase<pg8::EpiResid, pg8::StaticOrder, 0, F8_DOWN(layer)>(lds, g, S, E, tid);
        }
        SEAM(P + 9);
        }

    if (IN(20)) {
        PH_ENTER();
        const float* g_fin = KA_IN(ka, 10); float* outp = KA_OUT(ka); const h16* xf = XF;
        f32x4 ga[4], gb[4];
#pragma unroll
        for (int j = 0; j < 4; ++j) { ga[j] = *(const f32x4*)(g_fin + 8 * (lane + 64 * j)); gb[j] = *(const f32x4*)(g_fin + 8 * (lane + 64 * j) + 4); }
        for (int m0 = gw; m0 < M; m0 += 2 * NGW) {
            const int m1 = (m0 + NGW < M) ? m0 + NGW : m0;
            u32x4 r0[4], r1[4];
#pragma unroll
            for (int j = 0; j < 4; ++j) { r0[j] = *((const u32x4*)(xf + (size_t)m0 * DM) + lane + 64 * j); r1[j] = *((const u32x4*)(xf + (size_t)m1 * DM) + lane + 64 * j); }
            f32x4 va[4], vb[4], wa[4], wb[4]; float s0 = 0.f, s1 = 0.f;
#pragma unroll
            for (int j = 0; j < 4; ++j) { pg8::unpack8h(r0[j], va[j], vb[j]); pg8::unpack8h(r1[j], wa[j], wb[j]);
                s0 += (va[j].x * va[j].x + va[j].y * va[j].y) + (va[j].z * va[j].z + va[j].w * va[j].w) + (vb[j].x * vb[j].x + vb[j].y * vb[j].y) + (vb[j].z * vb[j].z + vb[j].w * vb[j].w);
                s1 += (wa[j].x * wa[j].x + wa[j].y * wa[j].y) + (wa[j].z * wa[j].z + wa[j].w * wa[j].w) + (wb[j].x * wb[j].x + wb[j].y * wb[j].y) + (wb[j].z * wb[j].z + wb[j].w * wb[j].w); }
            const float q0 = 1.0f / sqrtf(wave_sum(s0) * (1.0f / DM) + RMS_EPS), q1 = 1.0f / sqrtf(wave_sum(s1) * (1.0f / DM) + RMS_EPS);
            float* o0 = outp + (size_t)m0 * DM; float* o1 = outp + (size_t)m1 * DM;
#pragma unroll
            for (int j = 0; j < 4; ++j) { *(f32x4*)(o0 + 8 * (lane + 64 * j)) = va[j] * q0 * ga[j]; *(f32x4*)(o0 + 8 * (lane + 64 * j) + 4) = vb[j] * q0 * gb[j];
                                          *(f32x4*)(o1 + 8 * (lane + 64 * j)) = wa[j] * q1 * ga[j]; *(f32x4*)(o1 + 8 * (lane + 64 * j) + 4) = wb[j] * q1 * gb[j]; }
        }
    }
#undef IN
#undef SEAM
}

extern "C" void kernel_launch(void* const* d_in, const int* in_sizes, int n_in, void* d_out, int out_size, void* d_ws, size_t ws_size, hipStream_t stream) {
    static int grid = 0;
    if (grid == 0) {
        if (n_in != 12 || in_sizes[0] != M * DM || out_size != M * DM || ws_size < WS_END) {
            fprintf(stderr, "kernel_launch: unexpected shapes / workspace (n_in %d, in0 %d, out %d, ws %zu, need %zu); nothing launched\n", n_in, n_in > 0 ? in_sizes[0] : -1, out_size, ws_size, (size_t)WS_END);
            grid = -1; return; }
        int dev = 0, cus = 0, per_cu = 0;
        if (hipGetDevice(&dev) != hipSuccess || hipDeviceGetAttribute(&cus, hipDeviceAttributeMultiprocessorCount, dev) != hipSuccess) { grid = -1; return; }
        if (hipFuncSetAttribute((const void*)fwd_kernel, hipFuncAttributeMaxDynamicSharedMemorySize, LDS_BYTES) != hipSuccess) { fprintf(stderr, "kernel_launch: hipFuncSetAttribute failed\n"); grid = -1; return; }
        if (hipOccupancyMaxActiveBlocksPerMultiprocessor(&per_cu, (const void*)fwd_kernel, NTHREADS, LDS_BYTES) != hipSuccess || per_cu < 1)
            fprintf(stderr, "kernel_launch: note: occupancy query reports %d workgroups per CU\n", per_cu);
        (void)hipGetLastError();
        grid = cus;
    }
    if (grid < 0) return;
    if (hipMemsetAsync((char*)d_ws + WS_CTL, 0, CTL_ZERO_BYTES, stream) != hipSuccess) return;
    Args a{};
    for (int i = 0; i < 12; ++i) a.in[i] = (const float*)d_in[i];
    a.out = (float*)d_out; a.ws = (unsigned char*)d_ws;
#if MK_PER_PHASE_LAUNCH
    for (int p = 0; p <= 20; ++p) { a.ph_lo = p; a.ph_hi = p + 1; hipLaunchKernelGGL(fwd_kernel, dim3(grid), dim3(NTHREADS), LDS_BYTES, stream, a); }
#else
    a.ph_lo = 0; a.ph_hi = 21;
    hipLaunchKernelGGL(fwd_kernel, dim3(grid), dim3(NTHREADS), LDS_BYTES, stream, a);
#endif
    const hipError_t le = hipPeekAtLastError();
    if (le != hipSuccess) fprintf(stderr, "kernel_launch: launch failed: %s\n", hipGetErrorName(le));
}
```

```cpp
#include <hip/hip_runtime.h>
#include <cstdio>
#include <cstdint>

#ifndef MK_PER_PHASE_LAUNCH
#define MK_PER_PHASE_LAUNCH 0
#endif

#ifndef PROBE_MASK
#define PROBE_MASK 0
#endif
#ifndef F8_DOWN_MASK
#define F8_DOWN_MASK 2
#endif
#define F8_DOWN(l) (((F8_DOWN_MASK) >> (l)) & 1)
#define PH_REP(k) _Pragma("unroll 1") for (int rep_ = 0; rep_ < 1 + ((PROBE_MASK >> (k)) & 1); ++rep_)
#define LAS __attribute__((address_space(3)))
#define GAS __attribute__((address_space(1)))
typedef _Float16 h16;
typedef _Float16 h16x8 __attribute__((ext_vector_type(8)));
typedef _Float16 h16x4 __attribute__((ext_vector_type(4)));
typedef _Float16 h16x2 __attribute__((ext_vector_type(2)));
typedef float f32x2 __attribute__((ext_vector_type(2)));
typedef float f32x4 __attribute__((ext_vector_type(4)));
typedef float f32x16 __attribute__((ext_vector_type(16)));
typedef unsigned u32x2 __attribute__((ext_vector_type(2)));
typedef unsigned u32x4 __attribute__((ext_vector_type(4)));
typedef short v4i16_t __attribute__((ext_vector_type(4)));
typedef int v4i32 __attribute__((ext_vector_type(4)));
typedef int v8i32 __attribute__((ext_vector_type(8)));
typedef GAS unsigned gu32;
template <int N> struct IC { static constexpr int value = N; };

constexpr int BATCH = 4, SEQ = 4096, DM = 2048, DEPTH = 2, M = BATCH * SEQ;
constexpr int WIDTH_A = 1536, WIDTH_B = 1024, NIDX = 16, IDXD = 64;
constexpr int DIN = 12880, NP1 = 13056;
constexpr int DFF = 5632, NGU = 2 * DFF;
constexpr int TOPK = 256;
constexpr float RMS_EPS = 1e-6f;
constexpr float LOG2E = 1.4426950408889634f;
constexpr float C2 = 0.08838834764831845f * LOG2E;

constexpr size_t MiB = 1u << 20;
constexpr size_t WS_CTL = 0, CTL_ZERO_BYTES = 32 * 1024;
constexpr size_t WS_W1 = 1 * MiB, WS_WA = 52 * MiB, WS_WB = 54 * MiB, WS_WO = 58 * MiB, WS_WGU = 66 * MiB, WS_WD = 110 * MiB;
constexpr size_t WS_H16 = 132 * MiB;
constexpr size_t WS_QA = 196 * MiB, WS_KA = 244 * MiB, WS_VA = 292 * MiB;
constexpr size_t WS_QB = 340 * MiB, WS_KB = 372 * MiB, WS_VB = 404 * MiB;
constexpr size_t WS_QI = 436 * MiB, WS_KI = 468 * MiB, WS_WI = 470 * MiB, WS_LSE = 471 * MiB;
constexpr size_t WS_GA = 472 * MiB, WS_GB = 536 * MiB;
constexpr size_t WS_X = 600 * MiB;
constexpr size_t WS_END = 776 * MiB;
constexpr int CW_BAR = 4096;

constexpr int RING_BYTES = 131072;
constexpr int LDSCTL_OFF = RING_BYTES, MISC_OFF = LDSCTL_OFF + 320;
constexpr int LDS_BYTES = 147456;
constexpr int NWAVES = 8, NTHREADS = 512;

__device__ __forceinline__ unsigned pkh(float lo, float hi) { f32x2 v = {lo, hi}; h16x2 b = __builtin_convertvector(v, h16x2); return __builtin_bit_cast(unsigned, b); }
__device__ __forceinline__ unsigned pkf8(float a, float b, float c, float d) { int w = __builtin_amdgcn_cvt_pk_fp8_f32(a, b, 0, false); w = __builtin_amdgcn_cvt_pk_fp8_f32(c, d, w, true); return (unsigned)w; }
__device__ __forceinline__ v8i32 cat8(h16x8 a, h16x8 b) { return __builtin_shufflevector(__builtin_bit_cast(v4i32, a), __builtin_bit_cast(v4i32, b), 0, 1, 2, 3, 4, 5, 6, 7); }
__device__ __forceinline__ float relu_imax(float x) { const int i = __float_as_int(x); return __int_as_float(i > 0 ? i : 0); }
#define I1_RELU(x) relu_imax(x)
__device__ __forceinline__ float sig255_(float x, float c1) { return __builtin_amdgcn_rcpf(fmaf(__builtin_amdgcn_exp2f(x * c1), 1.0f / 255.0f, 1.0f / 255.0f)); }
__device__ __forceinline__ float sigmoidf_(float x) { return __builtin_amdgcn_rcpf(1.0f + __builtin_amdgcn_exp2f(-x * LOG2E)); }
#define LDS_WAIT() asm volatile("s_waitcnt lgkmcnt(0)" ::: "memory")
#define VM_WAIT() asm volatile("s_waitcnt vmcnt(0)" ::: "memory")

namespace pg8 {
constexpr int BM = 256, BK = 64, HALF = 128, HTB = HALF * BK * 2, STAGE_BYTES = 8 * HTB, NXCD = 8, WGM = 8;
__host__ __device__ __forceinline__ int lds_byte(int r, int c) { const int st = (r >> 4) * 2 + (c >> 5), rr = r & 15, cc = c & 31, ob = rr * 64 + cc * 2; return st * 1024 + (ob ^ (((ob >> 9) & 1) << 5)); }
__host__ __device__ __forceinline__ void stage_rc(int b, int& R, int& C) { const int st = b / 1024, sb = b % 1024, swz = sb ^ (((sb >> 9) & 1) << 5); R = (st >> 1) * 16 + swz / 64; C = (st & 1) * 32 + (swz % 64) / 2; }
__host__ __device__ __forceinline__ int perm32(int rho) { const int n = rho >> 4, i = rho & 15; return 8 * (i >> 2) + 4 * n + (i & 3); }
struct Unit { int pm, pn; };
struct Gemm { const h16* A; const h16* Bt; int M, N, K; };
struct StaticOrder {
    int nM, nN, nwg, G, c;
    __host__ __device__ void init(int M_, int N_, int G_, int c_) { nM = M_ / BM; nN = N_ / BM; nwg = nM * nN; G = G_; c = c_; }
    __host__ __device__ bool next(int i, Unit& u) const {
        const long L = (long)i * G + c; if (L >= nwg) return false;
        int wgid = (int)L; { const int q = nwg / NXCD, r = nwg % NXCD, xcd = wgid % NXCD, off = wgid / NXCD; wgid = (xcd < r ? xcd * (q + 1) : r * (q + 1) + (xcd - r) * q) + off; }
        const int nig = WGM * nN, gid = wgid / nig, fm = gid * WGM, gsz = (nM - fm) < WGM ? (nM - fm) : WGM;
        u.pm = fm + ((wgid % nig) % gsz); u.pn = (wgid % nig) / gsz; return true;
    }
    __device__ __forceinline__ void a_ready(const Unit&) const {}
    __device__ __forceinline__ void done(const Unit&) const {}
};
struct IdxOrder {
    int x, cl, cpx;
    __host__ __device__ void init(int G_, int c_) { x = c_ % NXCD; cl = c_ / NXCD; cpx = G_ / NXCD; }
    __host__ __device__ bool next(int i, Unit& u) const { const int o = cl + i * cpx; if (o >= 40) return false; u.pm = 8 * x + (o & 7); u.pn = 30 + (o >> 3); return true; }
    __device__ __forceinline__ void a_ready(const Unit&) const {}
    __device__ __forceinline__ void done(const Unit&) const {}
};
struct F8Order {
    int x, cl, cpx;
    __host__ __device__ void init(int G_, int c_) { x = c_ % NXCD; cl = c_ / NXCD; cpx = G_ / NXCD; }
    __host__ __device__ bool next(int i, Unit& u) const {
        int o;
        if (cpx == 32) { if (i < 9) o = i * 32 + cl; else { if (cl < 8 || i >= 11) return false; o = 288 + (i - 9) * 24 + (cl - 8); } }
        else { o = cl + i * cpx; if (o >= 336) return false; }
        const int q = o >> 3; u.pm = 8 * x + (o & 7); u.pn = q < 26 ? q : q + 9; return true;
    }
    __device__ __forceinline__ void a_ready(const Unit&) const {}
    __device__ __forceinline__ void done(const Unit&) const {}
};
struct VtOrder {
    int x, cl, cpx;
    __host__ __device__ void init(int G_, int c_) { x = c_ % NXCD; cl = c_ / NXCD; cpx = G_ / NXCD; }
    __host__ __device__ bool next(int i, Unit& u) const { const int o = cl + i * cpx; if (o >= 32) return false; u.pm = 26 + (o >> 3); u.pn = 8 * x + (o & 7); return true; }
    __device__ __forceinline__ void a_ready(const Unit&) const {}
    __device__ __forceinline__ void done(const Unit&) const {}
};
template <class Epi, class Sched, int TMID = 0, bool F8 = false>
__device__ __forceinline__ void gemm_phase(LAS unsigned char* lds, const Gemm g, const Sched& S, const Epi& E, const int tid) {
    const int wid = __builtin_amdgcn_readfirstlane(tid >> 6), lane = tid & 63, wr = wid >> 2, wc = wid & 3, fr = lane & 15, fq = lane >> 4;
    const int K = g.K, RB = F8 ? K : 2 * K, nt = RB / 128;
    unsigned voffA[2], voffB[2];
#pragma unroll
    for (int i = 0; i < 2; ++i) { int R, C; stage_rc(tid * 16 + i * 8192, R, C); const int Rb = Epi::PERM ? ((R & ~31) + perm32(R & 31)) : R;
        voffA[i] = (unsigned)(R * RB + C * 2); voffB[i] = (unsigned)(Rb * RB + C * 2); }
    const size_t kstep = (size_t)(BK * 2);
    const size_t hstep = (size_t)HALF * RB;
    const size_t tstep = 2 * hstep;
    const unsigned ldsw = (unsigned)wid * 1024u;
    const int aoff = lds_byte(wr * 64 + fr, fq * 8); int boff = lds_byte(wc * 32 + fr, fq * 8) + 4 * HTB;
    asm volatile("" : "+v"(boff));
#define PG8_SA(b, h) (((b) * 2 + (h)) * HTB)
#define PG8_SB(b, h) ((4 + (b) * 2 + (h)) * HTB)
#define PG8_STAGE(bufoff, gbase, voff) do { if constexpr (F8) { unsigned vo_ = (voff)[0]; const char* g0_ = (const char*)(gbase); const char* g1_ = g0_ + 64 * RB; asm volatile("" : "+v"(vo_), "+s"(g0_), "+s"(g1_)); \
        __builtin_amdgcn_global_load_lds((const unsigned*)(g0_ + vo_), (LAS unsigned*)(lds + (bufoff) + ldsw), 16, 0, 0); __builtin_amdgcn_global_load_lds((const unsigned*)(g1_ + vo_), (LAS unsigned*)(lds + (bufoff) + ldsw + 8192), 16, 0, 0); } \
      else { _Pragma("unroll") for (int _i = 0; _i < 2; ++_i) \
        __builtin_amdgcn_global_load_lds((const unsigned*)((const char*)(gbase) + (voff)[_i]), (LAS unsigned*)(lds + (bufoff) + ldsw + _i * 8192), 16, 0, 0); } } while (0)
#define PG8_LDA(dst, b, h) do { _Pragma("unroll") for (int m = 0; m < 4; ++m) _Pragma("unroll") for (int k = 0; k < 2; ++k) dst[m][k] = *(const LAS h16x8*)(lds + PG8_SA(b, h) + aoff + m * 2048 + k * 1024); } while (0)
#define PG8_LDB(dst, b, h) do { _Pragma("unroll") for (int n = 0; n < 2; ++n) _Pragma("unroll") for (int k = 0; k < 2; ++k) dst[n][k] = *(const LAS h16x8*)(lds + ((b) * 2 + (h)) * HTB + boff + n * 2048 + k * 1024); } while (0)
#define PG8_MMA(ai, bj, At, Bt) do { __builtin_amdgcn_s_setprio(1); _Pragma("unroll") for (int m = 0; m < 4; ++m) _Pragma("unroll") for (int n = 0; n < 2; ++n) { \
        if constexpr (F8) acc[ai][bj][m][n] = __builtin_amdgcn_mfma_scale_f32_16x16x128_f8f6f4(cat8(Bt[n][0], Bt[n][1]), cat8(At[m][0], At[m][1]), acc[ai][bj][m][n], 0, 0, 0, 0, 0, 0); \
        else { _Pragma("unroll") for (int k = 0; k < 2; ++k) acc[ai][bj][m][n] = __builtin_amdgcn_mfma_f32_16x16x32_f16(Bt[n][k], At[m][k], acc[ai][bj][m][n], 0, 0, 0); } } \
        __builtin_amdgcn_s_setprio(0); } while (0)
#define PG8_WAIT_V(n) asm volatile("s_waitcnt vmcnt(" #n ")" ::: "memory")
#define PG8_WAIT_L(n) asm volatile("s_waitcnt lgkmcnt(" #n ")" ::: "memory")
#define PG8_BAR __builtin_amdgcn_s_barrier()
#define PG8_SCHED __builtin_amdgcn_sched_barrier(0)
    Unit cur, nxt; int ui = 0;
    if (!S.next(0, cur)) return;
    f32x4 acc[2][2][4][2];
#pragma unroll
    for (int a = 0; a < 2; ++a)
#pragma unroll
        for (int b = 0; b < 2; ++b)
#pragma unroll
            for (int m = 0; m < 4; ++m)
#pragma unroll
                for (int n = 0; n < 2; ++n) acc[a][b][m][n] = (f32x4){0.f, 0.f, 0.f, 0.f};
    h16x8 At[4][2], B0[2][2], B1[2][2];
    const char* cA = (const char*)g.A + (size_t)cur.pm * tstep; const char* cB = (const char*)g.Bt + (size_t)cur.pn * tstep;
    S.a_ready(cur);
    PG8_STAGE(PG8_SB(0, 0), cB, voffB); PG8_STAGE(PG8_SB(0, 1), cB + hstep, voffB); PG8_STAGE(PG8_SA(0, 0), cA, voffA); PG8_STAGE(PG8_SA(0, 1), cA + hstep, voffA);
    if (wr == 1) PG8_BAR;
    PG8_WAIT_V(2); PG8_BAR;
    PG8_STAGE(PG8_SB(1, 0), cB + kstep, voffB); PG8_STAGE(PG8_SA(1, 0), cA + kstep, voffA); PG8_STAGE(PG8_SB(1, 1), cB + hstep + kstep, voffB);
    PG8_WAIT_V(6); PG8_BAR;
    for (;;) {
        const bool has_next = S.next(ui + 1, nxt);
        const char* nA = has_next ? (const char*)g.A + (size_t)nxt.pm * tstep : cA; const char* nB = has_next ? (const char*)g.Bt + (size_t)nxt.pn * tstep : cB;
        for (int t = 0; t < nt; t += 2) {
            const bool last = (t == nt - 2);
            const char* a1 = cA + (size_t)(t + 1) * kstep;
            const char* a2 = last ? nA : cA + (size_t)(t + 2) * kstep; const char* b2 = last ? nB : cB + (size_t)(t + 2) * kstep;
            const char* a3 = a2 + kstep; const char* b3 = b2 + kstep;
            if (last && has_next) S.a_ready(nxt);
            if constexpr (TMID != 0) { if (t == TMID) { E.mid(acc, cur, wr, wc, fr, fq); PG8_SCHED; } }
            PG8_LDB(B0, 0, 0); PG8_LDB(B1, 0, 1); PG8_SCHED; PG8_LDA(At, 0, 0); PG8_STAGE(PG8_SA(1, 1), a1 + hstep, voffA);
            PG8_WAIT_V(8); PG8_WAIT_L(0); PG8_BAR; PG8_MMA(0, 0, At, B0); PG8_MMA(0, 1, At, B1); PG8_BAR; PG8_SCHED;
            PG8_LDA(At, 0, 1); PG8_STAGE(PG8_SB(0, 0), b2, voffB); PG8_STAGE(PG8_SB(0, 1), b2 + hstep, voffB); PG8_STAGE(PG8_SA(0, 0), a2, voffA);
            PG8_WAIT_V(8); PG8_WAIT_L(0); PG8_BAR; PG8_MMA(1, 0, At, B0); PG8_MMA(1, 1, At, B1); PG8_BAR; PG8_SCHED;
            PG8_LDB(B0, 1, 0); PG8_LDB(B1, 1, 1); PG8_SCHED; PG8_LDA(At, 1, 0); PG8_STAGE(PG8_SA(0, 1), a2 + hstep, voffA);
            PG8_WAIT_V(8); PG8_WAIT_L(0); PG8_BAR; PG8_MMA(0, 0, At, B0); PG8_MMA(0, 1, At, B1); PG8_BAR; PG8_SCHED;
            PG8_LDA(At, 1, 1); PG8_STAGE(PG8_SB(1, 0), b3, voffB); PG8_STAGE(PG8_SB(1, 1), b3 + hstep, voffB); PG8_STAGE(PG8_SA(1, 0), a3, voffA);
            PG8_WAIT_V(8); PG8_WAIT_L(0); PG8_BAR; PG8_MMA(1, 0, At, B0); PG8_MMA(1, 1, At, B1); PG8_BAR; PG8_SCHED;
        }
        if (wr == 0) PG8_BAR;
        E(acc, cur, wr, wc, fr, fq); S.done(cur);
        if (!has_next) break;
#pragma unroll
        for (int a = 0; a < 2; ++a)
#pragma unroll
            for (int b = 0; b < 2; ++b)
#pragma unroll
                for (int m = 0; m < 4; ++m)
#pragma unroll
                    for (int n = 0; n < 2; ++n) acc[a][b][m][n] = (f32x4){0.f, 0.f, 0.f, 0.f};
        cur = nxt; cA = nA; cB = nB; ++ui;
        if (wr == 1) PG8_BAR;
    }
    PG8_WAIT_V(0);
    PG8_BAR;
#undef PG8_SA
#undef PG8_SB
#undef PG8_STAGE
#undef PG8_LDA
#undef PG8_LDB
#undef PG8_MMA
#undef PG8_WAIT_V
#undef PG8_WAIT_L
#undef PG8_BAR
#undef PG8_SCHED
}

__device__ __forceinline__ u32x4 pack8h(f32x4 a, f32x4 b) { u32x4 w; w.x = pkh(a[0], a[1]); w.y = pkh(a[2], a[3]); w.z = pkh(b[0], b[1]); w.w = pkh(b[2], b[3]); return w; }
__device__ __forceinline__ void unpack8h(u32x4 w, f32x4& a, f32x4& b) {
    const h16x8 h = __builtin_bit_cast(h16x8, w);
    a = (f32x4){(float)h[0], (float)h[1], (float)h[2], (float)h[3]}; b = (f32x4){(float)h[4], (float)h[5], (float)h[6], (float)h[7]};
}
struct EpiProj {
    static constexpr bool PERM = true;
    h16 *QA, *QB, *QI, *KI; unsigned char* G8; float* WI; float osc;
    __device__ __forceinline__ void operator()(const f32x4 (&acc)[2][2][4][2], const Unit& u, int wr, int wc, int fr, int fq) const {
        { int z_ = 0; asm volatile("" : "+v"(z_)); const int ln_ = (int)__builtin_amdgcn_mbcnt_hi(~0u, __builtin_amdgcn_mbcnt_lo(~0u, (unsigned)z_)); fr = ln_ & 15; fq = ln_ >> 4; }
        const int pn = u.pn; const int row0 = u.pm * BM + wr * 64 + fr, colw = wc * 32 + 8 * fq;
        if (pn == 34) {
#pragma unroll
            for (int ai = 0; ai < 2; ++ai)
#pragma unroll
                for (int m = 0; m < 4; ++m) { const size_t row = (size_t)(row0 + ai * HALF + m * 16);
                    if (wc < 2) *(u32x4*)(KI + row * 64 + colw) = pack8h(acc[ai][0][m][0] * osc, acc[ai][0][m][1] * osc);
                    else if (wc == 2 && fq < 2) { *(f32x4*)(WI + row * 16 + 8 * fq) = acc[ai][0][m][0] * osc; *(f32x4*)(WI + row * 16 + 8 * fq + 4) = acc[ai][0][m][1] * osc; } }
            return;
        }
        if (pn >= 18 && pn < 26) {
            const int q = pn - 18, s = q >> 2; unsigned char* b8 = (unsigned char*)(QB + (size_t)s * M * WIDTH_B) + (q - 4 * s) * BM + colw;
#pragma unroll
            for (int ai = 0; ai < 2; ++ai)
#pragma unroll
                for (int m = 0; m < 4; ++m) { unsigned char* rowp = b8 + (size_t)(row0 + ai * HALF + m * 16) * WIDTH_B;
#pragma unroll
                    for (int bj = 0; bj < 2; ++bj) { const f32x4 v0 = acc[ai][bj][m][0] * osc, v1 = acc[ai][bj][m][1] * osc;
                        *(u32x2*)(rowp + bj * HALF) = (u32x2){pkf8(v0[0], v0[1], v0[2], v0[3]), pkf8(v1[0], v1[1], v1[2], v1[3])}; } }
            return; }
        if (pn < 12) {
            const int s = pn / 6; unsigned char* b8 = (unsigned char*)(QA + (size_t)s * M * WIDTH_A) + (pn - 6 * s) * BM + colw;
#pragma unroll
            for (int ai = 0; ai < 2; ++ai)
#pragma unroll
                for (int m = 0; m < 4; ++m) { unsigned char* rowp = b8 + (size_t)(row0 + ai * HALF + m * 16) * WIDTH_A;
#pragma unroll
                    for (int bj = 0; bj < 2; ++bj) { const f32x4 v0 = acc[ai][bj][m][0] * osc, v1 = acc[ai][bj][m][1] * osc;
                        *(u32x2*)(rowp + bj * HALF) = (u32x2){pkf8(v0[0], v0[1], v0[2], v0[3]), pkf8(v1[0], v1[1], v1[2], v1[3])}; } }
            return; }
        h16* base; int ldc, colt; bool sig = false;
        if (pn < 18) { const int s = pn / 6; base = QA + (size_t)s * M * WIDTH_A; ldc = WIDTH_A; colt = (pn - 6 * s) * BM; }
        else if (pn < 30) { const int q = pn - 18, s = q / 4; base = QB + (size_t)s * M * WIDTH_B; ldc = WIDTH_B; colt = (q - 4 * s) * BM; }
        else if (pn < 34) { base = QI; ldc = 1024; colt = (pn - 30) * BM; }
        else {
            const int q = pn - 35, s8 = q / 8; unsigned char* gb_ = G8 + (size_t)s8 * M * DM + (q - 8 * s8) * BM + colw;
            const float c1_ = -osc * LOG2E;
#pragma unroll
            for (int ai = 0; ai < 2; ++ai)
#pragma unroll
                for (int m = 0; m < 4; ++m) { unsigned char* rowp = gb_ + (size_t)(row0 + ai * HALF + m * 16) * DM;
#pragma unroll
                    for (int bj = 0; bj < 2; ++bj) { u32x2 w = {0u, 0u};
#pragma unroll
                        for (int e = 0; e < 4; ++e) { w.x = __builtin_amdgcn_cvt_pk_u8_f32(sig255_(acc[ai][bj][m][0][e], c1_), e, w.x); w.y = __builtin_amdgcn_cvt_pk_u8_f32(sig255_(acc[ai][bj][m][1][e], c1_), e, w.y); }
                        *(u32x2*)(rowp + bj * HALF) = w; } }
            return; }
#pragma unroll
        for (int ai = 0; ai < 2; ++ai)
#pragma unroll
            for (int m = 0; m < 4; ++m) { h16* rowp = base + (size_t)(row0 + ai * HALF + m * 16) * ldc + colt + colw;
#pragma unroll
                for (int bj = 0; bj < 2; ++bj) { f32x4 v0 = acc[ai][bj][m][0] * osc, v1 = acc[ai][bj][m][1] * osc;
                    if (sig) {
#pragma unroll
                        for (int e = 0; e < 4; ++e) { v0[e] = sigmoidf_(v0[e]); v1[e] = sigmoidf_(v1[e]); } }
                    *(u32x4*)(rowp + bj * HALF) = pack8h(v0, v1); } }
    }
};
struct EpiVT {
    static constexpr bool PERM = true;
    unsigned char* VT; float osc;
    __device__ __forceinline__ void operator()(const f32x4 (&acc)[2][2][4][2], const Unit& u, int wr, int wc, int fr, int fq) const {
        { int z_ = 0; asm volatile("" : "+v"(z_)); const int ln_ = (int)__builtin_amdgcn_mbcnt_hi(~0u, __builtin_amdgcn_mbcnt_lo(~0u, (unsigned)z_)); fr = ln_ & 15; fq = ln_ >> 4; }
        const int wt = u.pm - 26, tokt = u.pn, b = tokt >> 4;
#pragma unroll
        for (int ai = 0; ai < 2; ++ai) { const int bh = b * 8 + 2 * wt + ai;
#pragma unroll
            for (int m = 0; m < 4; ++m) { const int d = 64 * wr + 16 * m + fr;
#pragma unroll
                for (int bj = 0; bj < 2; ++bj) { const int t64 = 4 * (tokt & 15) + 2 * bj + (wc >> 1);
                    unsigned char* q = VT + ((size_t)((bh * 64 + t64) * 128 + d) * 64 + 16 * (wc & 1) + 4 * fq);
#pragma unroll
                    for (int n = 0; n < 2; ++n) { const f32x4 v = acc[ai][bj][m][n] * osc; *(unsigned*)(q + 32 * n) = pkf8(v[0], v[1], v[2], v[3]); } } } }
    }
};
struct EpiMerge {
    static constexpr bool PERM = true;
    const unsigned char* Ga; const unsigned char* Gb; unsigned char* Out;
    static __device__ __forceinline__ void unpk(u32x2 q, f32x4& g0, f32x4& g1) { const unsigned a_ = q.x, b_ = q.y;
        g0 = (f32x4){(float)(a_ & 0xffu), (float)((a_ >> 8) & 0xffu), (float)((a_ >> 16) & 0xffu), (float)(a_ >> 24)};
        g1 = (f32x4){(float)(b_ & 0xffu), (float)((b_ >> 8) & 0xffu), (float)((b_ >> 16) & 0xffu), (float)(b_ >> 24)}; }
    __device__ __forceinline__ void mid(f32x4 (&acc)[2][2][4][2], const Unit& u, int wr, int wc, int fr, int fq) const {
        int row0 = u.pm * BM + wr * 64 + fr, col0 = u.pn * BM + wc * 32 + 8 * fq;
        asm volatile("" : "+v"(row0), "+v"(col0));
#pragma unroll
        for (int ai = 0; ai < 2; ++ai) {
            u32x2 qa[4][2], qb[4][2];
#pragma unroll
            for (int m = 0; m < 4; ++m) { const size_t off = (size_t)(row0 + ai * HALF + m * 16) * DM + col0;
#pragma unroll
                for (int bj = 0; bj < 2; ++bj) { qa[m][bj] = *(const u32x2*)(Ga + off + bj * HALF); qb[m][bj] = *(const u32x2*)(Gb + off + bj * HALF); } }
#pragma unroll
            for (int m = 0; m < 4; ++m)
#pragma unroll
                for (int bj = 0; bj < 2; ++bj) { f32x4 a0, a1, b0, b1; unpk(qa[m][bj], a0, a1); unpk(qb[m][bj], b0, b1);
#pragma unroll
                    for (int e = 0; e < 4; ++e) { acc[ai][bj][m][0][e] *= a0[e] * __builtin_amdgcn_rcpf(fmaxf(b0[e], 0.5f)); acc[ai][bj][m][1][e] *= a1[e] * __builtin_amdgcn_rcpf(fmaxf(b1[e], 0.5f)); } }
            asm volatile("" ::: "memory"); }
    }
    __device__ __forceinline__ void operator()(const f32x4 (&acc)[2][2][4][2], const Unit& u, int wr, int wc, int fr, int fq) const {
        int row0 = u.pm * BM + wr * 64 + fr, col0 = u.pn * BM + wc * 32 + 8 * fq;
        asm volatile("" : "+v"(row0), "+v"(col0));
#pragma unroll
        for (int ai = 0; ai < 2; ++ai) {
            u32x2 qb[4][2];
#pragma unroll
            for (int m = 0; m < 4; ++m) { const size_t off = (size_t)(row0 + ai * HALF + m * 16) * DM + col0;
#pragma unroll
                for (int bj = 0; bj < 2; ++bj) qb[m][bj] = *(const u32x2*)(Gb + off + bj * HALF); }
#pragma unroll
            for (int m = 0; m < 4; ++m) { const size_t off = (size_t)(row0 + ai * HALF + m * 16) * DM + col0;
#pragma unroll
                for (int bj = 0; bj < 2; ++bj) { f32x4 b0, b1; unpk(qb[m][bj], b0, b1); f32x4 v0, v1;
#pragma unroll
                    for (int e = 0; e < 4; ++e) { v0[e] = acc[ai][bj][m][0][e] * (fmaxf(b0[e], 0.5f) * (1.0f / (255.0f * 32.0f))); v1[e] = acc[ai][bj][m][1][e] * (fmaxf(b1[e], 0.5f) * (1.0f / (255.0f * 32.0f))); }
                    *(u32x2*)(Out + off + bj * HALF) = (u32x2){pkf8(v0[0], v0[1], v0[2], v0[3]), pkf8(v1[0], v1[1], v1[2], v1[3])}; } }
            asm volatile("" ::: "memory"); }
    }
};
struct EpiResid {
    static constexpr bool PERM = true;
    const h16* base; h16* out; float osc;
    __device__ __forceinline__ void operator()(const f32x4 (&acc)[2][2][4][2], const Unit& u, int wr, int wc, int fr, int fq) const {
        const int row0 = u.pm * BM + wr * 64 + fr, col0 = u.pn * BM + wc * 32 + 8 * fq;
#pragma unroll
        for (int ai = 0; ai < 2; ++ai) {
            u32x4 bq[4][2];
#pragma unroll
            for (int m = 0; m < 4; ++m) { const size_t off = (size_t)(row0 + ai * HALF + m * 16) * DM + col0;
#pragma unroll
                for (int bj = 0; bj < 2; ++bj) bq[m][bj] = *(const u32x4*)(base + off + bj * HALF); }
#pragma unroll
            for (int m = 0; m < 4; ++m) { const size_t off = (size_t)(row0 + ai * HALF + m * 16) * DM + col0;
#pragma unroll
                for (int bj = 0; bj < 2; ++bj) { f32x4 b0, b1; unpack8h(bq[m][bj], b0, b1);
                    *(u32x4*)(out + off + bj * HALF) = pack8h(b0 + acc[ai][bj][m][0] * osc, b1 + acc[ai][bj][m][1] * osc); } }
            asm volatile("" ::: "memory"); }
    }
};
template <bool O8>
struct EpiSwiglu {
    static constexpr bool PERM = true;
    h16* HID;
    __device__ __forceinline__ void operator()(const f32x4 (&acc)[2][2][4][2], const Unit& u, int wr, int wc, int fr, int fq) const {
        const int row0 = u.pm * BM + wr * 64 + fr, col0 = u.pn * HALF + wc * 32 + 8 * fq;
#pragma unroll
        for (int ai = 0; ai < 2; ++ai)
#pragma unroll
            for (int m = 0; m < 4; ++m) { f32x4 o[2];
#pragma unroll
                for (int n = 0; n < 2; ++n)
#pragma unroll
                    for (int e = 0; e < 4; ++e) { const float gt = acc[ai][0][m][n][e], up = acc[ai][1][m][n][e]; o[n][e] = (gt * up) * __builtin_amdgcn_rcpf(1.0f + __builtin_amdgcn_exp2f(-gt)); }
                if (O8) *(u32x2*)((unsigned char*)HID + (size_t)(row0 + ai * HALF + m * 16) * DFF + col0) = (u32x2){pkf8(o[0][0] * 4.f, o[0][1] * 4.f, o[0][2] * 4.f, o[0][3] * 4.f), pkf8(o[1][0] * 4.f, o[1][1] * 4.f, o[1][2] * 4.f, o[1][3] * 4.f)};
                else __builtin_nontemporal_store(pack8h(o[0], o[1]), (u32x4*)(HID + (size_t)(row0 + ai * HALF + m * 16) * DFF + col0)); }
    }
};
}

#define XB_TMO      128
#define XB_XCNT(j)  (256  + 64 * (j))
#define XB_XSUB(j)  (1280 + 64 * (j))
#define XB_XGEN(j)  (2304 + 64 * (j))
#define XB_TOP      3328
#define XB_TOPGEN   3392
#define XCD_BAR_WORDS 3456
#define XB_SPIN_CAP (1u << 18)
static_assert((CW_BAR + XCD_BAR_WORDS) * 4 <= (int)CTL_ZERO_BYTES, "barrier words inside the per-call memset");
__device__ __forceinline__ unsigned xb_ld(unsigned* p)              { return __hip_atomic_load(p, __ATOMIC_RELAXED, __HIP_MEMORY_SCOPE_AGENT); }
__device__ __forceinline__ unsigned xb_add(unsigned* p, unsigned v) { return __hip_atomic_fetch_add(p, v, __ATOMIC_RELAXED, __HIP_MEMORY_SCOPE_AGENT); }
__device__ __forceinline__ unsigned xb_xcc_id() { return (unsigned)__builtin_amdgcn_s_getreg((3 << 11) | 20) & 0xFu; }
#define XB_SPIN(cond, bar) do { unsigned _sp = 0; while (cond) { __builtin_amdgcn_s_sleep(1); \
    if ((++_sp & 255u) == 0u) { if (xb_ld(&(bar)[XB_TMO])) break; if (_sp > XB_SPIN_CAP) { atomicAdd(&(bar)[XB_TMO], 1u); break; } } } } while (0)
struct XcdBarrier { unsigned* bar; unsigned x; volatile LAS unsigned* st; };
__device__ __forceinline__ XcdBarrier xcd_barrier_post(unsigned* bar, volatile LAS unsigned* st) {
    XcdBarrier b; b.bar = bar; b.x = xb_xcc_id(); b.st = st;
    if (threadIdx.x == 0) (void)xb_add(&bar[XB_XCNT(b.x)], 1u);
    return b;
}
__device__ __forceinline__ void xcd_barrier_complete(unsigned* bar, unsigned x, unsigned& nloc, unsigned& nx) {
    const unsigned G = gridDim.x * gridDim.y * gridDim.z;
    unsigned sum, cnt, mine, sp = 0u;
    for (;;) {
        sum = 0u; cnt = 0u; mine = 0u;
#pragma unroll 1
        for (unsigned j = 0; j < 16; ++j) { const unsigned c = xb_ld(&bar[XB_XCNT(j)]); sum += c; cnt += (c > 0u) ? 1u : 0u; mine = (j == x) ? c : mine; }
        if (sum == G) break;
        __builtin_amdgcn_s_sleep(1);
        if ((++sp & 255u) == 0u) { if (xb_ld(&bar[XB_TMO])) break; if (sp > XB_SPIN_CAP) { atomicAdd(&bar[XB_TMO], 1u); break; } }
    }
    nloc = mine > 0u ? mine : 1u; nx = cnt > 0u ? cnt : 1u;
}
__device__ __forceinline__ void xcd_barrier(const XcdBarrier& b) {
    asm volatile("s_waitcnt vmcnt(0)" ::: "memory");
    __syncthreads();
    if (threadIdx.x == 0) {
        unsigned* bar = b.bar;
        __builtin_amdgcn_s_waitcnt(0);
        unsigned nloc = b.st[0], nx = b.st[1];
        if (nloc == 0u) { xcd_barrier_complete(bar, b.x, nloc, nx); b.st[0] = nloc; b.st[1] = nx; }
        const unsigned old = xb_add(&bar[XB_XSUB(b.x)], 1u);
        const unsigned gen = old / nloc;
        if (old + 1u == (gen + 1u) * nloc) {
            __builtin_amdgcn_fence(__ATOMIC_RELEASE, "agent");
            asm volatile("s_waitcnt vmcnt(0)" ::: "memory");
            const unsigned og = xb_add(&bar[XB_TOP], 1u);
            const unsigned tg = og / nx;
            if (og + 1u == (tg + 1u) * nx) xb_add(&bar[XB_TOPGEN], 1u);
            else XB_SPIN(xb_ld(&bar[XB_TOPGEN]) == tg, bar);
            __builtin_amdgcn_fence(__ATOMIC_ACQUIRE, "agent");
            xb_add(&bar[XB_XGEN(b.x)], 1u);
            asm volatile("s_waitcnt vmcnt(0)" ::: "memory");
        } else {
            XB_SPIN(xb_ld(&bar[XB_XGEN(b.x)]) == gen, bar);
            __builtin_amdgcn_fence(__ATOMIC_ACQUIRE, "agent");
            asm volatile("s_waitcnt vmcnt(0)" ::: "memory");
        }
    }
    __syncthreads();
}

__device__ __forceinline__ float wave_sum(float v) {
#define WS_DPP(x, ctrl) __builtin_bit_cast(float, __builtin_amdgcn_update_dpp(0, __builtin_bit_cast(int, (x)), (ctrl), 0xf, 0xf, false))
    v += WS_DPP(v, 0xB1); v += WS_DPP(v, 0x4E); v += WS_DPP(v, 0x141); v += WS_DPP(v, 0x140);
#undef WS_DPP
    const int iv = __builtin_bit_cast(int, v);
    return (__builtin_bit_cast(float, __builtin_amdgcn_readlane(iv, 0)) + __builtin_bit_cast(float, __builtin_amdgcn_readlane(iv, 16)))
         + (__builtin_bit_cast(float, __builtin_amdgcn_readlane(iv, 32)) + __builtin_bit_cast(float, __builtin_amdgcn_readlane(iv, 48)));
}
__device__ __forceinline__ int wave_sum_i(int v) {
#pragma unroll
    for (int o = 1; o < 64; o <<= 1) v += __shfl_xor(v, o);
    return v;
}
__device__ __forceinline__ int wave_sum_dpp(int v) {
    v += __builtin_amdgcn_update_dpp(0, v, 0xB1, 0xf, 0xf, false);
    v += __builtin_amdgcn_update_dpp(0, v, 0x4E, 0xf, 0xf, false);
    v += __builtin_amdgcn_update_dpp(0, v, 0x141, 0xf, 0xf, false);
    v += __builtin_amdgcn_update_dpp(0, v, 0x140, 0xf, 0xf, false);
    return __builtin_amdgcn_readlane(v, 0) + __builtin_amdgcn_readlane(v, 16) + __builtin_amdgcn_readlane(v, 32) + __builtin_amdgcn_readlane(v, 48);
}
template <bool F8>
__device__ __forceinline__ void rms_rows_h16(const h16* __restrict__ x, const float* __restrict__ g, h16* __restrict__ out, unsigned char* __restrict__ out8, int gw, int NGW, int lane) {
    f32x4 ga[4], gb[4];
#pragma unroll
    for (int j = 0; j < 4; ++j) { ga[j] = *(const f32x4*)(g + 8 * (lane + 64 * j)); gb[j] = *(const f32x4*)(g + 8 * (lane + 64 * j) + 4); }
    for (int m0 = gw; m0 < M; m0 += 2 * NGW) {
        const int m1 = (m0 + NGW < M) ? m0 + NGW : m0;
        u32x4 r0[4], r1[4];
#pragma unroll
        for (int j = 0; j < 4; ++j) { r0[j] = *((const u32x4*)(x + (size_t)m0 * DM) + lane + 64 * j); r1[j] = *((const u32x4*)(x + (size_t)m1 * DM) + lane + 64 * j); }
        f32x4 va[4], vb[4], wa[4], wb[4]; float s0 = 0.f, s1 = 0.f;
#pragma unroll
        for (int j = 0; j < 4; ++j) { pg8::unpack8h(r0[j], va[j], vb[j]); pg8::unpack8h(r1[j], wa[j], wb[j]);
            s0 += (va[j].x * va[j].x + va[j].y * va[j].y) + (va[j].z * va[j].z + va[j].w * va[j].w) + (vb[j].x * vb[j].x + vb[j].y * vb[j].y) + (vb[j].z * vb[j].z + vb[j].w * vb[j].w);
            s1 += (wa[j].x * wa[j].x + wa[j].y * wa[j].y) + (wa[j].z * wa[j].z + wa[j].w * wa[j].w) + (wb[j].x * wb[j].x + wb[j].y * wb[j].y) + (wb[j].z * wb[j].z + wb[j].w * wb[j].w); }
        const float q0 = 1.0f / sqrtf(wave_sum(s0) * (1.0f / DM) + RMS_EPS), q1 = 1.0f / sqrtf(wave_sum(s1) * (1.0f / DM) + RMS_EPS);
#pragma unroll
        for (int j = 0; j < 4; ++j) { const f32x4 ya = va[j] * q0 * ga[j], yb = vb[j] * q0 * gb[j], za = wa[j] * q1 * ga[j], zb = wb[j] * q1 * gb[j];
            *((u32x4*)(out + (size_t)m0 * DM) + lane + 64 * j) = pg8::pack8h(ya, yb); *((u32x4*)(out + (size_t)m1 * DM) + lane + 64 * j) = pg8::pack8h(za, zb);
            if (F8) { *((u32x2*)(out8 + (size_t)m0 * DM) + lane + 64 * j) = (u32x2){pkf8(ya.x, ya.y, ya.z, ya.w), pkf8(yb.x, yb.y, yb.z, yb.w)};
                      *((u32x2*)(out8 + (size_t)m1 * DM) + lane + 64 * j) = (u32x2){pkf8(za.x, za.y, za.z, za.w), pkf8(zb.x, zb.y, zb.z, zb.w)}; } }
    }
}
__device__ __forceinline__ int t5_bucket(int n) {
    if (n < 16) return n < 0 ? 0 : n;
    int b = 16;
    b += (n >= 22) + (n >= 30) + (n >= 40) + (n >= 54) + (n >= 73) + (n >= 99) + (n >= 134) + (n >= 182) + (n >= 246) + (n >= 332) + (n >= 450) + (n >= 609) + (n >= 825) + (n >= 1117) + (n >= 1513);
    return b;
}
constexpr int T5_FAR = 1513;

template <int MAP> __device__ __forceinline__ int dest_row(int n) {
    if (MAP == 1) return n < 8784 ? n : n + 176;
    if (MAP == 2) return 256 * (n >> 7) + (n & 127);
    if (MAP == 3) return 256 * (n >> 7) + 128 + (n & 127);
    return n;
}
template <int MAP, int OUT8 = 0>
__device__ __forceinline__ void transpose_item(const float* __restrict__ W, int K, int N, h16* __restrict__ WT, LAS float* scr, int item, int lane, int dpitch = 0, int dkoff = 0, unsigned char* __restrict__ WT8 = nullptr, float sc8 = 64.f) {
    if (dpitch == 0) dpitch = K;
    const int nblk = (N + 31) / 32, kb = item / nblk, nb = item - kb * nblk, k0 = 64 * kb, n0 = 32 * nb;
    const int nc = n0 + (lane & 31); const bool okc = nc < N;
    float wv_[32];
#pragma unroll
    for (int i = 0; i < 32; ++i) { const int kk = 2 * i + (lane >> 5); wv_[i] = okc ? W[(size_t)(k0 + kk) * N + nc] : 0.f; }
#pragma unroll
    for (int i = 0; i < 32; ++i) { const int kk = 2 * i + (lane >> 5); scr[kk * 33 + (lane & 31)] = wv_[i]; }
    LDS_WAIT(); asm volatile("" ::: "memory");
    if (MAP == 1 || OUT8) {
        const int c4 = lane & 3;
#pragma unroll
        for (int j = 0; j < 2; ++j) { const int n = (lane >> 2) + 16 * j; const LAS float* s = scr + (16 * c4) * 33 + n;
            u32x4 o; o.x = pkf8(s[0 * 33] * sc8, s[1 * 33] * sc8, s[2 * 33] * sc8, s[3 * 33] * sc8); o.y = pkf8(s[4 * 33] * sc8, s[5 * 33] * sc8, s[6 * 33] * sc8, s[7 * 33] * sc8);
            o.z = pkf8(s[8 * 33] * sc8, s[9 * 33] * sc8, s[10 * 33] * sc8, s[11 * 33] * sc8); o.w = pkf8(s[12 * 33] * sc8, s[13 * 33] * sc8, s[14 * 33] * sc8, s[15 * 33] * sc8);
            if (n0 + n < N) *(u32x4*)(WT8 + (size_t)dest_row<MAP>(n0 + n) * dpitch + dkoff + k0 + 16 * c4) = o; }
        if (OUT8 || !(n0 >= 7680 && n0 < 8784)) { LDS_WAIT(); asm volatile("" ::: "memory"); return; }
    }
    const int c = lane & 7;
#pragma unroll
    for (int j = 0; j < 4; ++j) { const int n = (lane >> 3) + 8 * j; const LAS float* s = scr + (8 * c) * 33 + n;
        const float c16 = MAP == 2 ? LOG2E : (MAP == 3 ? 1.0f / LOG2E : 1.0f);
        u32x4 o; o.x = pkh(s[0 * 33] * c16, s[1 * 33] * c16); o.y = pkh(s[2 * 33] * c16, s[3 * 33] * c16); o.z = pkh(s[4 * 33] * c16, s[5 * 33] * c16); o.w = pkh(s[6 * 33] * c16, s[7 * 33] * c16);
        if (n0 + n < N) *(u32x4*)(WT + (size_t)dest_row<MAP>(n0 + n) * dpitch + dkoff + k0 + 8 * c) = o; }
    LDS_WAIT(); asm volatile("" ::: "memory");
}

namespace att {
constexpr int KROW = 272, VROW = 320, KROW8 = 144, VROW8 = 80;
constexpr int KT_BYTES = 64 * KROW, VT_BYTES = 64 * VROW;
constexpr int OFF_K = 0, OFF_V = 2 * KT_BYTES, OFF_TAB = OFF_V + 2 * VT_BYTES;
constexpr int TABB_DMAX = 4095, TABB_N = 4096 + 128, TABA_DMAX = 255, TABA_N = 256 + 128;
static_assert(OFF_TAB + TABB_N * 4 <= RING_BYTES, "attention LDS");

struct UnitA { const h16* Q; const h16* K; const h16* V; const unsigned char* Q8; const unsigned char* K8; const unsigned char* V8; h16* O; float* lse; size_t pitch; size_t opitch; int lse_pitch; int q0; int t_lo, t_hi; };
__device__ __forceinline__ float max3_nc(float a, float b, float c) { float r; asm("v_max3_f32 %0, %1, %2, %3" : "=v"(r) : "v"(a), "v"(b), "v"(c)); return r; }
__device__ __forceinline__ float max2_nc(float a, float b) { float r; asm("v_max_f32 %0, %1, %2" : "=v"(r) : "v"(a), "v"(b)); return r; }
template <int MODE>
__device__ __forceinline__ void attn_tile(LAS unsigned char* kbuf, LAS unsigned char* vbuf, const LAS float* tab, const h16x8 (&qr)[4], f32x16 (&o)[4], float& m_run, float& l_run,
                                          const int kb_lane, const int vb_lane, const int kb0, const int tq, const int qlo, const int hi, const u32x2 mcur, const float bias_far) {
    constexpr int DMAX = MODE == 0 ? TABA_DMAX : TABB_DMAX;
        f32x16 p0, p1;
#pragma unroll
        for (int r = 0; r < 16; ++r) { p0[r] = 0.f; p1[r] = 0.f; }
        if constexpr (true) {
            const LAS unsigned char* kp = kbuf + kb_lane;
#pragma unroll
            for (int s = 0; s < 2; ++s) { const v8i32 qq = cat8(qr[2 * s], qr[2 * s + 1]);
                const v8i32 a0 = cat8(*(const LAS h16x8*)(kp + 64 * s), *(const LAS h16x8*)(kp + 64 * s + 16)), a1 = cat8(*(const LAS h16x8*)(kp + 32 * KROW8 + 64 * s), *(const LAS h16x8*)(kp + 32 * KROW8 + 64 * s + 16));
                p0 = __builtin_amdgcn_mfma_scale_f32_32x32x64_f8f6f4(a0, qq, p0, 0, 0, 0, 0, 0, 0);
                p1 = __builtin_amdgcn_mfma_scale_f32_32x32x64_f8f6f4(a1, qq, p1, 0, 0, 0, 0, 0, 0); }
        } else { const LAS unsigned char* kp = kbuf + kb_lane;
#pragma unroll
          for (int d0 = 0; d0 < 8; ++d0) { const h16x8 a0 = *(const LAS h16x8*)(kp + 32 * d0), a1 = *(const LAS h16x8*)(kp + 32 * KROW + 32 * d0);
              p0 = __builtin_amdgcn_mfma_f32_32x32x16_f16(a0, qr[d0], p0, 0, 0, 0);
              p1 = __builtin_amdgcn_mfma_f32_32x32x16_f16(a1, qr[d0], p1, 0, 0, 0); } }
        const int dq = tq - kb0 - 4 * hi;
        if (MODE == 1 && (qlo - (kb0 + 63) >= T5_FAR)) {
#pragma unroll
            for (int r = 0; r < 16; ++r) { p0[r] = fmaf(p0[r], C2, bias_far); p1[r] = fmaf(p1[r], C2, bias_far); }
        } else {
            const LAS float* tp = tab + (DMAX - dq);
#pragma unroll
            for (int r = 0; r < 16; ++r) { const int c = (r & 3) + 8 * (r >> 2); p0[r] = fmaf(p0[r], C2, tp[c]); p1[r] = fmaf(p1[r], C2, tp[c + 32]); }
        }
        const float NEG = -__builtin_inff();
        if (MODE == 0) {
#pragma unroll
            for (int r = 0; r < 16; ++r) { const int c = (r & 3) + 8 * (r >> 2);
                if ((unsigned)(dq - c) > 128u) p0[r] = NEG;
                if ((unsigned)(dq - c - 32) > 128u) p1[r] = NEG; }
        }
        float pmax;
        {
            float a_[11], b_[4];
#pragma unroll
            for (int g = 0; g < 5; ++g) { a_[2 * g] = max3_nc(p0[3 * g], p0[3 * g + 1], p0[3 * g + 2]); a_[2 * g + 1] = max3_nc(p1[3 * g], p1[3 * g + 1], p1[3 * g + 2]); }
            a_[10] = max2_nc(p0[15], p1[15]);
            b_[0] = max3_nc(a_[0], a_[1], a_[2]); b_[1] = max3_nc(a_[3], a_[4], a_[5]); b_[2] = max3_nc(a_[6], a_[7], a_[8]); b_[3] = max2_nc(a_[9], a_[10]);
            pmax = max2_nc(max2_nc(b_[0], b_[1]), max2_nc(b_[2], b_[3])); }
        { auto rr = __builtin_amdgcn_permlane32_swap(__float_as_uint(pmax), __float_as_uint(pmax), false, false);
          pmax = fmaxf(__uint_as_float(rr[0]), __uint_as_float(rr[1])); }
        float mn = m_run, alpha = 1.f;
        if (!__all(pmax - m_run <= 8.f)) {
            mn = fmaxf(m_run, pmax); alpha = __builtin_amdgcn_exp2f(m_run - mn); m_run = mn;
#pragma unroll
            for (int d = 0; d < 4; ++d)
#pragma unroll
                for (int r = 0; r < 16; ++r) o[d][r] *= alpha;
        }
#pragma unroll
        for (int r = 0; r < 16; r += 2) { const f32x2 mn2 = {mn, mn};
            const f32x2 t0 = (f32x2){p0[r], p0[r + 1]} - mn2, t1 = (f32x2){p1[r], p1[r + 1]} - mn2;
            p0[r] = __builtin_amdgcn_exp2f(t0.x); p0[r + 1] = __builtin_amdgcn_exp2f(t0.y); p1[r] = __builtin_amdgcn_exp2f(t1.x); p1[r + 1] = __builtin_amdgcn_exp2f(t1.y); }
        if (MODE == 1) {
            const unsigned m0 = mcur.x >> (4 * hi), m1 = mcur.y >> (4 * hi);
#pragma unroll
            for (int r = 0; r < 16; ++r) { const int c = (r & 3) + 8 * (r >> 2);
                int s0_, s1_; asm("v_bfe_i32 %0, %1, %2, 1" : "=v"(s0_) : "v"(m0), "n"(c)); asm("v_bfe_i32 %0, %1, %2, 1" : "=v"(s1_) : "v"(m1), "n"(c));
                p0[r] = __uint_as_float(__float_as_uint(p0[r]) & (unsigned)s0_);
                p1[r] = __uint_as_float(__float_as_uint(p1[r]) & (unsigned)s1_); }
        }
        float ps;
        { f32x2 a_[8];
#pragma unroll
          for (int r = 0; r < 8; ++r) a_[r] = (f32x2){p0[2 * r], p0[2 * r + 1]} + (f32x2){p1[2 * r], p1[2 * r + 1]};
#pragma unroll
          for (int w_ = 4; w_ >= 1; w_ >>= 1)
#pragma unroll
              for (int r = 0; r < w_; ++r) a_[r] += a_[r + w_];
          ps = a_[0].x + a_[0].y; }
        { auto rr = __builtin_amdgcn_permlane32_swap(__float_as_uint(ps), __float_as_uint(ps), false, false);
          ps = __uint_as_float(rr[0]) + __uint_as_float(rr[1]); }
        l_run = l_run * alpha + ps;
        if constexpr (MODE == 1) {
            v8i32 pb;
            pb[0] = (int)pkf8(p0[0], p0[1], p0[2], p0[3]); pb[1] = (int)pkf8(p0[4], p0[5], p0[6], p0[7]); pb[2] = (int)pkf8(p0[8], p0[9], p0[10], p0[11]); pb[3] = (int)pkf8(p0[12], p0[13], p0[14], p0[15]);
            pb[4] = (int)pkf8(p1[0], p1[1], p1[2], p1[3]); pb[5] = (int)pkf8(p1[4], p1[5], p1[6], p1[7]); pb[6] = (int)pkf8(p1[8], p1[9], p1[10], p1[11]); pb[7] = (int)pkf8(p1[12], p1[13], p1[14], p1[15]);
            const LAS unsigned char* vp = vbuf + vb_lane;
#pragma unroll
            for (int d = 0; d < 4; ++d)
                o[d] = __builtin_amdgcn_mfma_scale_f32_32x32x64_f8f6f4(cat8(*(const LAS h16x8*)(vp + 32 * VROW8 * d), *(const LAS h16x8*)(vp + 32 * VROW8 * d + 16)), pb, o[d], 0, 0, 0, 0, 0, 0);
            return;
        }
        h16x8 pf[4];
        { u32x4 w;
          w.x = pkh(p0[0], p0[1]); w.y = pkh(p0[2], p0[3]); w.z = pkh(p0[4], p0[5]); w.w = pkh(p0[6], p0[7]); pf[0] = __builtin_bit_cast(h16x8, w);
          w.x = pkh(p0[8], p0[9]); w.y = pkh(p0[10], p0[11]); w.z = pkh(p0[12], p0[13]); w.w = pkh(p0[14], p0[15]); pf[1] = __builtin_bit_cast(h16x8, w);
          w.x = pkh(p1[0], p1[1]); w.y = pkh(p1[2], p1[3]); w.z = pkh(p1[4], p1[5]); w.w = pkh(p1[6], p1[7]); pf[2] = __builtin_bit_cast(h16x8, w);
          w.x = pkh(p1[8], p1[9]); w.y = pkh(p1[10], p1[11]); w.z = pkh(p1[12], p1[13]); w.w = pkh(p1[14], p1[15]); pf[3] = __builtin_bit_cast(h16x8, w); }
        { const LAS unsigned char* vp = vbuf + vb_lane;
#pragma unroll
          for (int d = 0; d < 4; ++d)
#pragma unroll
              for (int s = 0; s < 4; ++s) {
                  const v4i16_t lo = __builtin_amdgcn_ds_read_tr16_b64_v4i16((LAS v4i16_t*)(vp + (16 * s) * VROW + 64 * d));
                  const v4i16_t hh = __builtin_amdgcn_ds_read_tr16_b64_v4i16((LAS v4i16_t*)(vp + (16 * s + 8) * VROW + 64 * d));
                  typedef short s16x8 __attribute__((ext_vector_type(8)));
                  const s16x8 vv = {lo[0], lo[1], lo[2], lo[3], hh[0], hh[1], hh[2], hh[3]};
                  o[d] = __builtin_amdgcn_mfma_f32_32x32x16_f16(__builtin_bit_cast(h16x8, vv), pf[s], o[d], 0, 0, 0); } }
}
template <int MODE>
__device__ __forceinline__ void attn_unit(LAS unsigned char* lds, const UnitA& U, const unsigned long long* __restrict__ mask, float bias_far, const int tid) {
    const int wid = __builtin_amdgcn_readfirstlane(tid >> 6), lane = tid & 63, r32 = lane & 31, hi = lane >> 5;
    const int qlo = U.q0 + 32 * wid, tq = qlo + r32;
    constexpr int DMAX = MODE == 0 ? TABA_DMAX : TABB_DMAX;
    const LAS float* tab = (const LAS float*)(lds + OFF_TAB);
    h16x8 qr[4];
    const int pitch8 = MODE == 1 ? WIDTH_B : (int)U.pitch;
    if constexpr (true) { const unsigned char* qp = U.Q8 + (size_t)(32 * wid + r32) * pitch8 + 32 * hi;
#pragma unroll
      for (int s = 0; s < 2; ++s) { qr[2 * s] = *(const h16x8*)(qp + 64 * s); qr[2 * s + 1] = *(const h16x8*)(qp + 64 * s + 16); }
    } else { const h16* qp = U.Q + (size_t)(32 * wid + r32) * U.pitch + 8 * hi;
#pragma unroll
      for (int d0 = 0; d0 < 8; ++d0) qr[d0] = *(const h16x8*)(qp + 16 * d0); }
    const int sr = tid >> 4, sc = tid & 15;
    const int pitch_i = (int)U.pitch;
    const unsigned goff = (unsigned)(sr * pitch_i + sc * 8) * 2u, ghalf = (unsigned)(32 * pitch_i) * 2u;
    const size_t tstride = (size_t)(64 * pitch_i) * 2u;
    const int kws = (tid >> 3) * KROW8 + (tid & 7) * 16, vws = sr * VROW + sc * 16;
    const unsigned goff8 = (unsigned)((tid >> 3) * pitch8 + (tid & 7) * 16);
    const int vws8 = (tid >> 2) * VROW8 + (tid & 3) * 16;
    h16x8 sA0, sA1, sA2, sA3, sB0, sB1, sB2, sB3;
#define ATT_LOADS(K0, K1, V0, V1, t) do { \
        if constexpr (MODE == 1) { const char* kb__ = (const char*)U.K8 + (size_t)(t) * (64 * WIDTH_B); K0 = *(const h16x8*)(kb__ + goff8); V0 = *(const h16x8*)((const char*)U.V8 + (size_t)(t) * 8192 + (unsigned)(tid * 16)); } \
        else { const char* kb__ = (const char*)U.K8 + (size_t)(t) * (size_t)(64 * pitch8); const char* vb__ = (const char*)U.V + (size_t)(t) * tstride; K0 = *(const h16x8*)(kb__ + goff8); \
               V0 = *(const h16x8*)(vb__ + goff); V1 = *(const h16x8*)(vb__ + ghalf + goff); } } while (0)
#define ATT_LOADM(t) (*(const u32x2*)((const char*)(mask + (t)) + moff))
#define ATT_WRITES(K0, K1, V0, V1, buf) do { LAS unsigned char* kb_ = lds + OFF_K + (buf) * KT_BYTES; LAS unsigned char* vb_ = lds + OFF_V + (buf) * VT_BYTES; \
        if constexpr (MODE == 1) { *(LAS h16x8*)(kb_ + kws) = K0; *(LAS h16x8*)(vb_ + vws8) = V0; } \
        else { *(LAS h16x8*)(kb_ + kws) = K0; *(LAS h16x8*)(vb_ + vws) = V0; *(LAS h16x8*)(vb_ + vws + 32 * VROW) = V1; } } while (0)
#define ATT_ACT(t) (MODE == 0 ? ((64 * (t) <= qlo + 31) && (64 * (t) + 63 >= qlo - 128)) : (64 * (t) <= qlo + 31))
    const int T0 = U.t_lo, T1 = U.t_hi;
    float zf_ = 0.f; asm volatile("" : "+v"(zf_));
    u32x2 mwA, mwB;
    const unsigned moff = (unsigned)tq * 512u;
    ATT_LOADS(sA0, sA1, sA2, sA3, T0); if (MODE == 1) { mwA = ATT_LOADM(T0); mwB = mwA; }
    if (T0 + 1 < T1) { ATT_LOADS(sB0, sB1, sB2, sB3, T0 + 1); if (MODE == 1) mwB = ATT_LOADM(T0 + 1); }
    float m_run = -1e30f, l_run = zf_;
    f32x16 o[4];
#pragma unroll
    for (int d = 0; d < 4; ++d)
#pragma unroll
        for (int r = 0; r < 16; ++r) o[d][r] = zf_;
    const int kb_lane = r32 * KROW8 + hi * 32;
    const int vb_lane = MODE == 1 ? r32 * VROW8 + hi * 32 : (4 * hi + ((lane >> 2) & 3)) * VROW + (16 * ((lane >> 4) & 1) + 4 * (lane & 3)) * 2;
    for (int t = T0; t < T1; t += 2) {
        {   ATT_WRITES(sA0, sA1, sA2, sA3, 0);
            __syncthreads();
            const u32x2 mcur = MODE == 1 ? mwA : (u32x2){0u, 0u};
            if (t + 2 < T1) { ATT_LOADS(sA0, sA1, sA2, sA3, t + 2); if (MODE == 1) mwA = ATT_LOADM(t + 2); }
            if (ATT_ACT(t)) attn_tile<MODE>(lds + OFF_K, lds + OFF_V, tab, qr, o, m_run, l_run, kb_lane, vb_lane, 64 * t, tq, qlo, hi, mcur, bias_far); }
        if (t + 1 < T1) {
            ATT_WRITES(sB0, sB1, sB2, sB3, 1);
            __syncthreads();
            const u32x2 mcur = MODE == 1 ? mwB : (u32x2){0u, 0u};
            if (t + 3 < T1) { ATT_LOADS(sB0, sB1, sB2, sB3, t + 3); if (MODE == 1) mwB = ATT_LOADM(t + 3); }
            if (ATT_ACT(t + 1)) attn_tile<MODE>(lds + OFF_K + KT_BYTES, lds + OFF_V + VT_BYTES, tab, qr, o, m_run, l_run, kb_lane, vb_lane, 64 * (t + 1), tq, qlo, hi, mcur, bias_far); }
    }
#undef ATT_LOADS
#undef ATT_LOADM
#undef ATT_WRITES
#undef ATT_ACT
    const float inv = l_run > 0.f ? 1.0f / l_run : 0.f;
    if (MODE == 1) {
        unsigned char* op8 = (unsigned char*)U.O + (size_t)(32 * wid + r32) * U.opitch + 4 * hi; const float i16 = inv * 16.f;
#pragma unroll
        for (int d = 0; d < 4; ++d)
#pragma unroll
            for (int g4 = 0; g4 < 4; ++g4) *(unsigned*)(op8 + 32 * d + 8 * g4) = pkf8(o[d][4 * g4] * i16, o[d][4 * g4 + 1] * i16, o[d][4 * g4 + 2] * i16, o[d][4 * g4 + 3] * i16);
    } else {
    h16* op = U.O + (size_t)(32 * wid + r32) * U.opitch + 4 * hi;
#pragma unroll
    for (int d = 0; d < 4; ++d)
#pragma unroll
        for (int g4 = 0; g4 < 4; ++g4) { u32x2 w; w.x = pkh(o[d][4 * g4] * inv, o[d][4 * g4 + 1] * inv); w.y = pkh(o[d][4 * g4 + 2] * inv, o[d][4 * g4 + 3] * inv);
            *(u32x2*)(op + 32 * d + 8 * g4) = w; } }
    if (MODE == 0 && hi == 0) U.lse[(size_t)(32 * wid + r32) * U.lse_pitch] = m_run + __builtin_amdgcn_logf(l_run);
}
}

struct Args { const float* in[12]; float* out; unsigned char* ws; int ph_lo, ph_hi; };
#define AS4 __attribute__((address_space(4)))
typedef const unsigned char AS4* kaptr;
__device__ __forceinline__ kaptr get_ka() { kaptr p = (kaptr)__builtin_amdgcn_kernarg_segment_ptr(); asm volatile("" : "+s"(p)); return p; }
#define KA_IN(ka, k) (*(const float* const AS4*)((ka) + 8 * (k)))
#define KA_OUT(ka) (*(float* const AS4*)((ka) + 96))
#define KA_WS(ka) (*(unsigned char* const AS4*)((ka) + 104))
#define KA_LO(ka) (*(const int AS4*)((ka) + 112))
#define KA_HI(ka) (*(const int AS4*)((ka) + 116))

__global__ void __launch_bounds__(NTHREADS, 2) fwd_kernel(Args args) {
    extern __shared__ __attribute__((aligned(16))) unsigned char lds_raw[];
    LAS unsigned char* lds = (LAS unsigned char*)lds_raw;
    volatile LAS unsigned* MISC = (volatile LAS unsigned*)(lds + MISC_OFF);
#define WSP(T, off) ((T*)(ws + (off)))
#define W1T WSP(h16, WS_W1)
#define WAB8 WSP(unsigned char, WS_WA)
#define W1F8 WSP(unsigned char, WS_W1)
#define H8 WSP(unsigned char, WS_X)
#define WO8 WSP(unsigned char, WS_WO)
#define WGUT WSP(h16, WS_WGU)
#define WDT WSP(h16, WS_WD)
#define H16 ((h16*)KA_OUT(ka))
#define XS ((h16*)KA_OUT(ka) + (size_t)M * DM)
#define XF WSP(h16, WS_H16)
#define OA WSP(h16, WS_H16)
#define QA WSP(h16, WS_QA)
#define KA WSP(h16, WS_KA)
#define VA WSP(h16, WS_VA)
#define YY8 WSP(unsigned char, WS_QA)
#define MASK WSP(unsigned long long, WS_VA)
#define QB WSP(h16, WS_QB)
#define KB WSP(h16, WS_KB)
#define VB WSP(h16, WS_VB)
#define VT8 WSP(unsigned char, WS_VB)
#define QI WSP(h16, WS_QI)
#define KI WSP(h16, WS_KI)
#define WI WSP(float, WS_WI)
#define LSE WSP(float, WS_LSE)
#define GA WSP(unsigned char, WS_GA)
#define GB (WSP(unsigned char, WS_GA) + (size_t)M * DM)
#define SC WSP(unsigned short, WS_X)
#define MG8 WSP(unsigned char, WS_X)
#define HID WSP(h16, WS_X)
#define FRESH_TID(name) int name; { int zt_ = 0; asm volatile("" : "+v"(zt_)); name = wave_s * 64 + (int)__builtin_amdgcn_mbcnt_hi(~0u, __builtin_amdgcn_mbcnt_lo(~0u, (unsigned)zt_)); asm volatile("" : "+v"(name)); }
#define PH_ENTER() const kaptr ka = get_ka(); unsigned char* const ws = KA_WS(ka); (void)ws; \
    int z_ = 0; asm volatile("" : "+v"(z_)); int tid = wave_s * 64 + (int)__builtin_amdgcn_mbcnt_hi(~0u, __builtin_amdgcn_mbcnt_lo(~0u, (unsigned)z_)); asm volatile("" : "+v"(tid)); int bx = blockIdx.x; asm volatile("" : "+s"(bx)); int G = gridDim.x; asm volatile("" : "+s"(G)); \
    const int lane = tid & 63, wave = __builtin_amdgcn_readfirstlane(tid >> 6), gw = bx * NWAVES + wave, NGW = G * NWAVES; (void)lane; (void)gw; (void)NGW
    for (int u = threadIdx.x; u < (LDS_BYTES - LDSCTL_OFF) / 4; u += NTHREADS) ((LAS unsigned*)(lds + LDSCTL_OFF))[u] = 0u;
    const int wave_s = __builtin_amdgcn_readfirstlane(threadIdx.x >> 6);
    __syncthreads();
    XcdBarrier bar; int lo, hi_ph;
    { const kaptr ka = get_ka(); unsigned* ctl = (unsigned*)(KA_WS(ka) + WS_CTL); lo = KA_LO(ka); hi_ph = KA_HI(ka);
      bar.bar = ctl + CW_BAR; bar.x = 0; bar.st = nullptr;
      if (!MK_PER_PHASE_LAUNCH) bar = xcd_barrier_post(ctl + CW_BAR, MISC + 8); }
#define IN(k) (lo <= (k) && (k) < hi_ph)
#define SEAM(k) do { if (!MK_PER_PHASE_LAUNCH && IN(k) && IN((k) + 1)) xcd_barrier(bar); } while (0)

    { constexpr int layer = 0;
        const int P = layer * 10;
        if (IN(P + 0)) PH_REP(0) {
            PH_ENTER();
            const float* w_in = KA_IN(ka, 1) + (size_t)layer * DM * DIN;
            const float* w_oa = KA_IN(ka, 2) + (size_t)layer * 512 * DM;
            const float* w_ob = KA_IN(ka, 3) + (size_t)layer * 1024 * DM;
            const float* w_o = KA_IN(ka, 4) + (size_t)layer * DM * DM;
            const float* w_fg = KA_IN(ka, 5) + (size_t)layer * DM * DFF;
            const float* w_fu = KA_IN(ka, 6) + (size_t)layer * DM * DFF;
            const float* w_fd = KA_IN(ka, 7) + (size_t)layer * DFF * DM;
            const float* g_mix = KA_IN(ka, 8) + (size_t)layer * DM;
            const float* xcur = KA_IN(ka, 0);
            LAS float* scr = (LAS float*)(lds + wave * 16384);
            constexpr int I1_ = (DM / 64) * ((DIN + 31) / 32), IG = (DM / 64) * (DFF / 32), ID = (DFF / 64) * (DM / 32), IA = (512 / 64) * (DM / 32), IB = (1024 / 64) * (DM / 32), IO = (DM / 64) * (DM / 32);
            constexpr int NITEMS = I1_ + 2 * IG + ID + IA + IB + IO;
            for (int it = gw; it < NITEMS; it += NGW) {
                int r = it;
                if (r < I1_) { transpose_item<1>(w_in, DM, DIN, W1T, scr, r, lane, 0, 0, W1F8); continue; } r -= I1_;
                if (r < IG) { transpose_item<2>(w_fg, DM, DFF, WGUT, scr, r, lane); continue; } r -= IG;
                if (r < IG) { transpose_item<3>(w_fu, DM, DFF, WGUT, scr, r, lane); continue; } r -= IG;
                if (r < ID) { if (F8_DOWN(layer)) transpose_item<0, 1>(w_fd, DFF, DM, nullptr, scr, r, lane, 0, 0, (unsigned char*)WDT, 128.f); else transpose_item<0>(w_fd, DFF, DM, WDT, scr, r, lane); continue; } r -= ID;
                if (r < IA) { transpose_item<0, 1>(w_oa, 512, DM, nullptr, scr, r, lane, 1536, 0, WAB8, 32.f); continue; } r -= IA;
                if (r < IB) { transpose_item<0, 1>(w_ob, 1024, DM, nullptr, scr, r, lane, 1536, 512, WAB8, 32.f); continue; } r -= IB;
                transpose_item<0, 1>(w_o, DM, DM, nullptr, scr, r, lane, 0, 0, WO8, 64.f);
            }
            { u32x4* z = (u32x4*)(W1T + (size_t)8784 * DM); const int nz = 176 * DM * 2 / 16;
              for (int i = bx * NTHREADS + tid; i < nz; i += G * NTHREADS) z[i] = (u32x4){0u, 0u, 0u, 0u}; }
            if (layer == 0) {
                f32x4 gv[8];
#pragma unroll
                for (int j = 0; j < 8; ++j) gv[j] = *((const f32x4*)g_mix + lane + 64 * j);
                for (int m = gw; m < M; m += NGW) {
                    const f32x4* xr = (const f32x4*)(xcur + (size_t)m * DM) + lane; f32x4 v[8]; float s = 0.f;
#pragma unroll
                    for (int j = 0; j < 8; ++j) { v[j] = xr[64 * j]; s += (v[j].x * v[j].x + v[j].y * v[j].y) + (v[j].z * v[j].z + v[j].w * v[j].w); }
                    const float rs = 1.0f / sqrtf(wave_sum(s) * (1.0f / DM) + RMS_EPS);
                    u32x2* o8 = (u32x2*)(H16 + (size_t)m * DM) + lane; u32x2* x8 = (u32x2*)(XS + (size_t)m * DM) + lane;
#pragma unroll
                    for (int j = 0; j < 8; ++j) { const f32x4 y = v[j] * rs * gv[j]; u32x2 w; w.x = pkh(y.x, y.y); w.y = pkh(y.z, y.w); o8[64 * j] = w;
                        ((unsigned*)(H8 + (size_t)m * DM))[lane + 64 * j] = pkf8(y.x, y.y, y.z, y.w);
                        u32x2 xw; xw.x = pkh(v[j].x, v[j].y); xw.y = pkh(v[j].z, v[j].w); x8[64 * j] = xw; }
                }
            } else {
                rms_rows_h16<true>(XS, g_mix, H16, H8, gw, NGW, lane);
            }
        }
        SEAM(P + 0);

        if (IN(P + 1)) PH_REP(1) {
            PH_ENTER();
            const bool idx_last = (bx >> 3) & 1;
            if (!idx_last) {
                pg8::Gemm g{H16, W1T, M, NP1, DM}; pg8::IdxOrder S; S.init(G, bx);
                pg8::EpiProj E{QA, QB, QI, KI, GA, WI, 1.0f};
                pg8::gemm_phase<pg8::EpiProj, pg8::IdxOrder, 0, false>(lds, g, S, E, tid); }
            { pg8::Gemm g{(const h16*)H8, (const h16*)W1F8, M, NP1, DM}; pg8::F8Order S; S.init(G, bx);
              pg8::EpiProj E{QA, QB, QI, KI, GA, WI, 1.0f / 64.0f};
              FRESH_TID(tid2); pg8::gemm_phase<pg8::EpiProj, pg8::F8Order, 0, true>(lds, g, S, E, tid2); }
            { pg8::Gemm g{(const h16*)W1F8, (const h16*)H8, NP1, M, DM}; pg8::VtOrder S; S.init(G, bx);
              pg8::EpiVT E{VT8, 1.0f / 64.0f};
              FRESH_TID(tid3); pg8::gemm_phase<pg8::EpiVT, pg8::VtOrder, 0, true>(lds, g, S, E, tid3); }
            if (idx_last) {
                int bx2 = blockIdx.x; asm volatile("" : "+s"(bx2)); int G2 = gridDim.x; asm volatile("" : "+s"(G2));
                pg8::Gemm g{H16, W1T, M, NP1, DM}; pg8::IdxOrder S; S.init(G2, bx2);
                pg8::EpiProj E{QA, QB, QI, KI, GA, WI, 1.0f};
                FRESH_TID(tid4); pg8::gemm_phase<pg8::EpiProj, pg8::IdxOrder, 0, false>(lds, g, S, E, tid4); }
        }
        SEAM(P + 1);

        if (IN(P + 2)) PH_REP(2) {
            PH_ENTER();
            const float* rel_bias = KA_IN(ka, 11);
            PH_REP(10) for (int u0 = bx; u0 < 768; u0 += G) {
                const int u = (u0 & 7) * 96 + (u0 >> 3);
                const int b = u / 192, rem = u - b * 192, g = rem >> 6, rem2 = rem & 63, hh = rem2 >> 4, xx = rem2 & 15;
                const int dil = g == 0 ? 1 : (g == 1 ? 4 : 16), nblk = 16 / dil, res = xx / nblk, blk = xx - res * nblk;
                __syncthreads();
                { LAS float* tabw = (LAS float*)(lds + att::OFF_TAB);
                  for (int i = tid; i < att::TABA_N; i += NTHREADS) { const int dist = att::TABA_DMAX - i;
                      tabw[i] = (dist >= 0 && dist <= 128) ? rel_bias[t5_bucket(dist * dil) * 20 + g * 4 + hh] * LOG2E : 0.f; } }
                att::UnitA U; const size_t base = ((size_t)b * SEQ + res) * WIDTH_A + g * 512 + hh * 128;
                U.pitch = (size_t)dil * WIDTH_A; U.opitch = U.pitch; U.q0 = 256 * blk;
                U.K = nullptr; U.Q = nullptr; U.K8 = (const unsigned char*)KA + base; U.Q8 = (const unsigned char*)QA + base + (size_t)U.q0 * U.pitch; U.V = VA + base; U.O = OA + base + (size_t)U.q0 * U.pitch;
                U.lse = LSE + ((size_t)b * SEQ + res + (size_t)U.q0 * dil) * 12 + g * 4 + hh; U.lse_pitch = dil * 12;
                U.t_lo = blk == 0 ? 0 : 4 * blk - 2; U.t_hi = 4 * blk + 4;
                att::attn_unit<0>(lds, U, nullptr, 0.f, tid);
            }
            __syncthreads();
            {
                LAS float* wT = (LAS float*)lds;
                float wnx[4]; h16x8 knx[4]; bool have_nx = false;
                auto i1_item = [&](auto tln_c, const int u, const int qs, const int kh, const int tl0, const int unext) {
                    constexpr int TLN = decltype(tln_c)::value;
                    int tid_u = tid; asm volatile("" : "+v"(tid_u));
                    const int lane_u = tid_u & 63, r32 = lane_u & 31, hi = lane_u >> 5;
                    const int b = u / 272; int rem = u - b * 272, i = 0;
                    { int p = 0; for (;;) { const int c = (i >> 1) + 1; if (rem < p + c) break; p += c; ++i; } rem -= p; }
                    const int j = rem;
                    float wpre[4]; h16x8 kpre[4];
                    if (have_nx) {
#pragma unroll
                        for (int e4 = 0; e4 < 4; ++e4) { wpre[e4] = wnx[e4]; kpre[e4] = knx[e4]; }
                    } else { const float* wg = WI + ((size_t)b * SEQ + 128 * i) * 16; const h16* kg = KI + ((size_t)b * SEQ + 256 * j) * 64;
#pragma unroll
                      for (int e4 = 0; e4 < 4; ++e4) { const int e = tid_u + NTHREADS * e4; wpre[e4] = wg[e]; kpre[e4] = *(const h16x8*)(kg + (size_t)(e >> 3) * 64 + (e & 7) * 8); } }
#define I1_PREFETCH() do { have_nx = unext >= 0; if (have_nx) { const int bn = unext / 272; int remn = unext - bn * 272, in_ = 0; { int p = 0; for (;;) { const int c = (in_ >> 1) + 1; if (remn < p + c) break; p += c; ++in_; } remn -= p; } \
                        const float* wg = WI + ((size_t)bn * SEQ + 128 * in_) * 16; const h16* kg = KI + ((size_t)bn * SEQ + 256 * remn) * 64; int tp_ = tid; asm volatile("" : "+v"(tp_)); \
                        _Pragma("unroll") for (int e4 = 0; e4 < 4; ++e4) { const int e = tp_ + NTHREADS * e4; wnx[e4] = wg[e]; knx[e4] = *(const h16x8*)(kg + (size_t)(e >> 3) * 64 + (e & 7) * 8); } } \
                        else { _Pragma("unroll") for (int e4 = 0; e4 < 4; ++e4) { wnx[e4] = 0.f; knx[e4] = (h16x8){0, 0, 0, 0, 0, 0, 0, 0}; } } } while (0)
                    __syncthreads();
#pragma unroll
                    for (int e4 = 0; e4 < 4; ++e4) { const int e = tid_u + NTHREADS * e4; wT[(e & 15) * 128 + (e >> 4)] = wpre[e4] * 0.03125f;
                        *(LAS h16x8*)(lds + 8192 + (e >> 3) * 144 + (e & 7) * 16) = kpre[e4]; }
                    __syncthreads();
                    if (2 * j + kh <= i) {
                    const size_t tok0 = (size_t)b * SEQ + 128 * i + 32 * qs;
                    const LAS unsigned char* kl = lds + 8192 + (128 * kh + 32 * tl0 + r32) * 144 + hi * 16;
                    f32x16 acc[TLN];
                    const char* qbase = (const char*)(QI + tok0 * 1024); const unsigned qoff = (unsigned)(r32 * 1024 + 8 * hi) * 2u;
                    h16x8 afA[4], afB[4];
                    h16x8 kf[TLN][4];
#pragma unroll
                    for (int tl = 0; tl < TLN; ++tl)
#pragma unroll
                        for (int ks = 0; ks < 4; ++ks) kf[tl][ks] = *(const LAS h16x8*)(kl + (32 * tl) * 144 + 32 * ks);
#define I1_LOAD(dst, h_) do { unsigned vo_ = qoff; const char* qb_ = qbase + (size_t)(128 * (h_)); asm volatile("" : "+v"(vo_), "+s"(qb_)); \
                        _Pragma("unroll") for (int ks = 0; ks < 4; ++ks) dst[ks] = *(const h16x8*)(qb_ + vo_ + 32 * ks); } while (0)
#define I1_HEAD(af, h_, FIRST) do { const float wq_ = wT[(h_) * 128 + 32 * qs + r32]; \
                        _Pragma("unroll") for (int tl = 0; tl < TLN; ++tl) { f32x16 d; \
                            _Pragma("unroll") for (int r = 0; r < 16; ++r) d[r] = 0.f; \
                            _Pragma("unroll") for (int ks = 0; ks < 4; ++ks) d = __builtin_amdgcn_mfma_f32_32x32x16_f16(kf[tl][ks], af[ks], d, 0, 0, 0); \
                            _Pragma("unroll") for (int r = 0; r < 16; ++r) acc[tl][r] = (FIRST) ? I1_RELU(d[r]) * wq_ : fmaf(I1_RELU(d[r]), wq_, acc[tl][r]); } } while (0)
                    I1_LOAD(afA, 0);
                    I1_LOAD(afB, 1);
                    I1_HEAD(afA, 0, true);
                    I1_LOAD(afA, 2);
                    I1_HEAD(afB, 1, false);
#pragma unroll 1
                    for (int h = 2; h < 16; h += 2) {
                        I1_LOAD(afB, h + 1);
                        I1_HEAD(afA, h, false);
                        if (h + 2 < 16) I1_LOAD(afA, h + 2);
                        I1_HEAD(afB, h + 1, false);
                    }
#undef I1_LOAD
#undef I1_HEAD
                    I1_PREFETCH();
                    const int Li = 128 * (i + 1);
                    int zs_ = 0; asm volatile("" : "+v"(zs_)); const int lane_s = (int)__builtin_amdgcn_mbcnt_hi(~0u, __builtin_amdgcn_mbcnt_lo(~0u, (unsigned)zs_)), r32s = lane_s & 31, his = lane_s >> 5;
                    unsigned short* sp = SC + ((size_t)b * 528 + (size_t)(i * (i + 1) / 2)) * 16384 + (size_t)(32 * qs + r32s) * Li + 256 * j + 128 * kh + 32 * tl0 + 8 * his;
#pragma unroll
                    for (int tl = 0; tl < TLN; ++tl)
#pragma unroll
                        for (int pg = 0; pg < 2; ++pg) { const int g = 2 * pg;
                            const unsigned a0 = pkh(acc[tl][4 * g], acc[tl][4 * g + 1]), a1 = pkh(acc[tl][4 * g + 2], acc[tl][4 * g + 3]), b0 = pkh(acc[tl][4 * g + 4], acc[tl][4 * g + 5]), b1 = pkh(acc[tl][4 * g + 6], acc[tl][4 * g + 7]);
                            const auto s0 = __builtin_amdgcn_permlane32_swap(a0, b0, false, false), s1 = __builtin_amdgcn_permlane32_swap(a1, b1, false, false);
                            *(u32x4*)(sp + 32 * tl + 16 * pg) = (u32x4){s0[0], s1[0], s0[1], s1[1]}; }
                    } else { I1_PREFETCH(); }
#undef I1_PREFETCH
                };
                PH_REP(11) { const int nfull = G == 256 ? 1024 : 1088;
                    const int uq = G == 256 ? (bx & 7) * 136 + 128 + (bx >> 5) : -1;
                    for (int u0 = bx; u0 < nfull; u0 += G) { const int un = u0 + G; i1_item(IC<4>{}, (u0 & 7) * 136 + (u0 >> 3), wave & 3, wave >> 2, 0, un < nfull ? (un & 7) * 136 + (un >> 3) : uq); }
                    if (G == 256) i1_item(IC<1>{}, uq, (bx >> 3) & 3, wave >> 2, wave & 3, -1); }
            }
        }
        SEAM(P + 2);

        if (IN(P + 3)) PH_REP(3) {
            PH_ENTER();
            PH_REP(12) for (int it = gw; it < M; it += NGW) {
                const int b = it >> 12, t0_ = it & 4095, t = t0_ < 2048 ? t0_ : 6143 - t0_, rw = (b << 12) + t, i = t >> 7, rr = t & 127, n = t + 1, nj = (n + 63) >> 6;
                const unsigned short* row = SC + ((size_t)b * 528 + (size_t)(i * (i + 1) / 2)) * 16384 + (size_t)rr * (128 * (i + 1));
                unsigned mlo = 0u, mhi = 0u;
#define TK_PUT(j, bl) do { const bool me_ = lane == (j); mlo = me_ ? (unsigned)(bl) : mlo; mhi = me_ ? (unsigned)((bl) >> 32) : mhi; asm volatile("" : "+v"(mlo), "+v"(mhi)); } while (0)
                if (n <= TOPK) {
#pragma unroll
                    for (int j = 0; j < 4; ++j) { const unsigned long long bl = __ballot(64 * j + lane < n); TK_PUT(j, bl); }
                } else {
                    unsigned uk[64];
#pragma unroll
                    for (int j = 0; j < 64; ++j) uk[j] = 0u;
#pragma unroll
                    for (int g8 = 0; g8 < 8; ++g8) if (8 * g8 < nj) {
#pragma unroll
                        for (int jj = 0; jj < 8; ++jj) { const int k = 64 * (8 * g8 + jj) + lane; uk[8 * g8 + jj] = (unsigned)row[k < n ? k : n - 1]; } }
#pragma unroll
                    for (int g8 = 0; g8 < 8; ++g8) if (8 * g8 < nj) {
#pragma unroll
                        for (int jj = 0; jj < 8; ++jj) { const int j = 8 * g8 + jj, k = 64 * j + lane;
                            unsigned bits = uk[j]; if (bits == 0x8000u) bits = 0u;
                            const unsigned key = (bits & 0x8000u) ? (~bits & 0xffffu) : (bits | 0x8000u); uk[j] = k < n ? key : 0u; } }
                    unsigned T = 0u; bool exact = false;
                    for (int bit = 15; bit >= 0; --bit) {
                        const unsigned cand = T | (1u << bit); int cl = 0;
#pragma unroll
                        for (int g8 = 0; g8 < 8; ++g8) if (8 * g8 < nj) {
#pragma unroll
                            for (int jj = 0; jj < 8; ++jj) cl += (uk[8 * g8 + jj] >= cand) ? 1 : 0; }
                        const int c = wave_sum_dpp(cl);
                        if (c >= TOPK) { T = cand; if (c == TOPK) { exact = true; break; } }
                    }
                    if (exact) {
#pragma unroll
                        for (int g8 = 0; g8 < 8; ++g8) if (8 * g8 < nj) {
#pragma unroll
                            for (int jj = 0; jj < 8; ++jj) { const unsigned long long bs = __ballot(uk[8 * g8 + jj] >= T); TK_PUT(8 * g8 + jj, bs); } }
                    } else {
                        int cgl = 0;
#pragma unroll
                        for (int g8 = 0; g8 < 8; ++g8) if (8 * g8 < nj) {
#pragma unroll
                            for (int jj = 0; jj < 8; ++jj) cgl += (uk[8 * g8 + jj] > T) ? 1 : 0; }
                        const int need = TOPK - wave_sum_dpp(cgl); int tb = 0;
#pragma unroll
                        for (int g8 = 0; g8 < 8; ++g8) if (8 * g8 < nj) {
#pragma unroll
                            for (int jj = 0; jj < 8; ++jj) { const int j = 8 * g8 + jj;
                                const bool eq = uk[j] == T; const unsigned long long be = __ballot(eq);
                                const int rank = tb + __builtin_amdgcn_mbcnt_hi((unsigned)(be >> 32), __builtin_amdgcn_mbcnt_lo((unsigned)be, 0u));
                                const bool sel = (uk[j] > T) || (eq && rank < need);
                                const unsigned long long bs = __ballot(sel); TK_PUT(j, bs);
                                tb += __popcll(be); } }
                    }
                }
#undef TK_PUT
                *(u32x2*)(MASK + (size_t)rw * 64 + lane) = (u32x2){mlo, mhi};
            }
            PH_REP(13) for (int rw0 = gw; rw0 < M; rw0 += 2 * NGW) {
                const int hh = lane >> 4, dd = (lane & 15) * 8;
                int rws[2]; rws[0] = rw0; rws[1] = (rw0 + NGW < M) ? rw0 + NGW : rw0;
                float lq[2][3]; u32x4 oq[2][3];
#pragma unroll
                for (int q = 0; q < 2; ++q) { const float* lp = LSE + (size_t)rws[q] * 12 + hh; lq[q][0] = lp[0]; lq[q][1] = lp[4]; lq[q][2] = lp[8];
                    const h16* op = OA + (size_t)rws[q] * WIDTH_A + hh * 128 + dd; oq[q][0] = *(const u32x4*)(op); oq[q][1] = *(const u32x4*)(op + 512); oq[q][2] = *(const u32x4*)(op + 1024); }
#pragma unroll
                for (int q = 0; q < 2; ++q) {
                    const float mx = fmaxf(lq[q][0], fmaxf(lq[q][1], lq[q][2]));
                    float w0 = __builtin_amdgcn_exp2f(lq[q][0] - mx), w1 = __builtin_amdgcn_exp2f(lq[q][1] - mx), w2 = __builtin_amdgcn_exp2f(lq[q][2] - mx);
                    const float inv = 1.0f / (w0 + w1 + w2); w0 *= inv; w1 *= inv; w2 *= inv;
                    f32x4 a0, a1, b0, b1, c0, c1;
                    pg8::unpack8h(oq[q][0], a0, a1); pg8::unpack8h(oq[q][1], b0, b1); pg8::unpack8h(oq[q][2], c0, c1);
                    const f32x4 y0 = a0 * w0 + b0 * w1 + c0 * w2, y1 = a1 * w0 + b1 * w1 + c1 * w2;
                    *(u32x2*)(YY8 + (size_t)rws[q] * 1536 + hh * 128 + dd) = (u32x2){pkf8(y0.x * 16.f, y0.y * 16.f, y0.z * 16.f, y0.w * 16.f), pkf8(y1.x * 16.f, y1.y * 16.f, y1.z * 16.f, y1.w * 16.f)};
                }
            }
        }
        SEAM(P + 3);

        if (IN(P + 4)) PH_REP(4) {
            PH_ENTER();
            const float* rel_bias = KA_IN(ka, 11);
            for (int pu = bx; pu < 256; pu += G) {
                const int xcd_ = pu & 7, slot_ = pu >> 3, bh = 8 * (slot_ >> 3) + xcd_, pr = slot_ & 7, b = bh >> 3, h = bh & 7;
                for (int pass = 0; pass < 2; ++pass) {
                    const int qb = pass == 0 ? 15 - pr : pr;
                    __syncthreads();
                    { LAS float* tabw = (LAS float*)(lds + att::OFF_TAB);
                      for (int i = tid; i < att::TABB_N; i += NTHREADS) { const int dist = att::TABB_DMAX - i;
                          tabw[i] = dist >= 0 ? rel_bias[t5_bucket(dist) * 20 + 12 + h] * LOG2E : 0.f; } }
                    att::UnitA U; const size_t base = (size_t)b * SEQ * WIDTH_B + h * 128;
                    U.pitch = WIDTH_B; U.opitch = 1536; U.q0 = 256 * qb;
                    U.K = nullptr; U.Q = nullptr; U.K8 = (const unsigned char*)KB + base; U.Q8 = (const unsigned char*)QB + base + (size_t)U.q0 * WIDTH_B; U.V = nullptr; U.V8 = VT8 + (size_t)(b * 8 + h) * (64 * 8192); U.O = (h16*)(YY8 + ((size_t)b * SEQ + U.q0) * 1536 + 512 + h * 128);
                    U.lse = nullptr; U.lse_pitch = 0; U.t_lo = 0; U.t_hi = 4 * qb + 4;
                    att::attn_unit<1>(lds, U, MASK + (size_t)b * SEQ * 64, rel_bias[31 * 20 + 12 + h] * LOG2E, tid);
                }
            }
            __syncthreads();
        }
        SEAM(P + 4);

        if (IN(P + 5)) PH_REP(5) {
            PH_ENTER();
            pg8::Gemm g{(const h16*)YY8, (const h16*)WAB8, M, DM, 1536}; pg8::StaticOrder S; S.init(M, DM, G, bx); pg8::EpiMerge E{GA, GB, MG8};
            pg8::gemm_phase<pg8::EpiMerge, pg8::StaticOrder, 4, true>(lds, g, S, E, tid);
        }
        SEAM(P + 5);

        if (IN(P + 6)) PH_REP(6) {
            PH_ENTER();
            pg8::Gemm g{(const h16*)MG8, (const h16*)WO8, M, DM, DM}; pg8::StaticOrder S; S.init(M, DM, G, bx); pg8::EpiResid E{XS, XS, 1.0f / 1024.0f};
            pg8::gemm_phase<pg8::EpiResid, pg8::StaticOrder, 0, true>(lds, g, S, E, tid);
        }
        SEAM(P + 6);

        if (IN(P + 7)) PH_REP(7) {
            PH_ENTER();
            const float* g_ffn = KA_IN(ka, 9) + (size_t)layer * DM;
            rms_rows_h16<false>(XS, g_ffn, H16, nullptr, gw, NGW, lane);
        }
        SEAM(P + 7);

        if (IN(P + 8)) PH_REP(8) {
            PH_ENTER();
            pg8::Gemm g{H16, WGUT, M, NGU, DM}; pg8::StaticOrder S; S.init(M, NGU, G, bx); pg8::EpiSwiglu<F8_DOWN(layer)> E{HID};
            pg8::gemm_phase<pg8::EpiSwiglu<F8_DOWN(layer)>, pg8::StaticOrder>(lds, g, S, E, tid);
        }
        SEAM(P + 8);

        if (IN(P + 9)) PH_REP(9) {
            PH_ENTER();
            pg8::Gemm g{HID, WDT, M, DM, DFF}; pg8::StaticOrder S; S.init(M, DM, G, bx); pg8::EpiResid E{XS, layer + 1 < DEPTH ? XS : XF, F8_DOWN(layer) ? 1.0f / 512.0f : 1.0f};
            pg8::gemm_phase<pg8::EpiResid, pg8::StaticOrder, 0, F8_DOWN(layer)>(lds, g, S, E, tid);
        }
        SEAM(P + 9);
        }
    { constexpr int layer = 1;
        const int P = layer * 10;
        if (IN(P + 0)) PH_REP(0) {
            PH_ENTER();
            const float* w_in = KA_IN(ka, 1) + (size_t)layer * DM * DIN;
            const float* w_oa = KA_IN(ka, 2) + (size_t)layer * 512 * DM;
            const float* w_ob = KA_IN(ka, 3) + (size_t)layer * 1024 * DM;
            const float* w_o = KA_IN(ka, 4) + (size_t)layer * DM * DM;
            const float* w_fg = KA_IN(ka, 5) + (size_t)layer * DM * DFF;
            const float* w_fu = KA_IN(ka, 6) + (size_t)layer * DM * DFF;
            const float* w_fd = KA_IN(ka, 7) + (size_t)layer * DFF * DM;
            const float* g_mix = KA_IN(ka, 8) + (size_t)layer * DM;
            const float* xcur = KA_IN(ka, 0);
            LAS float* scr = (LAS float*)(lds + wave * 16384);
            constexpr int I1_ = (DM / 64) * ((DIN + 31) / 32), IG = (DM / 64) * (DFF / 32), ID = (DFF / 64) * (DM / 32), IA = (512 / 64) * (DM / 32), IB = (1024 / 64) * (DM / 32), IO = (DM / 64) * (DM / 32);
            constexpr int NITEMS = I1_ + 2 * IG + ID + IA + IB + IO;
            for (int it = gw; it < NITEMS; it += NGW) {
                int r = it;
                if (r < I1_) { transpose_item<1>(w_in, DM, DIN, W1T, scr, r, lane, 0, 0, W1F8); continue; } r -= I1_;
                if (r < IG) { transpose_item<2>(w_fg, DM, DFF, WGUT, scr, r, lane); continue; } r -= IG;
                if (r < IG) { transpose_item<3>(w_fu, DM, DFF, WGUT, scr, r, lane); continue; } r -= IG;
                if (r < ID) { if (F8_DOWN(layer)) transpose_item<0, 1>(w_fd, DFF, DM, nullptr, scr, r, lane, 0, 0, (unsigned char*)WDT, 128.f); else transpose_item<0>(w_fd, DFF, DM, WDT, scr, r, lane); continue; } r -= ID;
                if (r < IA) { transpose_item<0, 1>(w_oa, 512, DM, nullptr, scr, r, lane, 1536, 0, WAB8, 32.f); continue; } r -= IA;
                if (r < IB) { transpose_item<0, 1>(w_ob, 1024, DM, nullptr, scr, r, lane, 1536, 512, WAB8, 32.f); continue; } r -= IB;
                transpose_item<0, 1>(w_o, DM, DM, nullptr, scr, r, lane, 0, 0, WO8, 64.f);
            }
            { u32x4* z = (u32x4*)(W1T + (size_t)8784 * DM); const int nz = 176 * DM * 2 / 16;
              for (int i = bx * NTHREADS + tid; i < nz; i += G * NTHREADS) z[i] = (u32x4){0u, 0u, 0u, 0u}; }
            if (layer == 0) {
                f32x4 gv[8];
#pragma unroll
                for (int j = 0; j < 8; ++j) gv[j] = *((const f32x4*)g_mix + lane + 64 * j);
                for (int m = gw; m < M; m += NGW) {
                    const f32x4* xr = (const f32x4*)(xcur + (size_t)m * DM) + lane; f32x4 v[8]; float s = 0.f;
#pragma unroll
                    for (int j = 0; j < 8; ++j) { v[j] = xr[64 * j]; s += (v[j].x * v[j].x + v[j].y * v[j].y) + (v[j].z * v[j].z + v[j].w * v[j].w); }
                    const float rs = 1.0f / sqrtf(wave_sum(s) * (1.0f / DM) + RMS_EPS);
                    u32x2* o8 = (u32x2*)(H16 + (size_t)m * DM) + lane; u32x2* x8 = (u32x2*)(XS + (size_t)m * DM) + lane;
#pragma unroll
                    for (int j = 0; j < 8; ++j) { const f32x4 y = v[j] * rs * gv[j]; u32x2 w; w.x = pkh(y.x, y.y); w.y = pkh(y.z, y.w); o8[64 * j] = w;
                        ((unsigned*)(H8 + (size_t)m * DM))[lane + 64 * j] = pkf8(y.x, y.y, y.z, y.w);
                        u32x2 xw; xw.x = pkh(v[j].x, v[j].y); xw.y = pkh(v[j].z, v[j].w); x8[64 * j] = xw; }
                }
            } else {
                rms_rows_h16<true>(XS, g_mix, H16, H8, gw, NGW, lane);
            }
        }
        SEAM(P + 0);

        if (IN(P + 1)) PH_REP(1) {
            PH_ENTER();
            const bool idx_last = (bx >> 3) & 1;
            if (!idx_last) {
                pg8::Gemm g{H16, W1T, M, NP1, DM}; pg8::IdxOrder S; S.init(G, bx);
                pg8::EpiProj E{QA, QB, QI, KI, GA, WI, 1.0f};
                pg8::gemm_phase<pg8::EpiProj, pg8::IdxOrder, 0, false>(lds, g, S, E, tid); }
            { pg8::Gemm g{(const h16*)H8, (const h16*)W1F8, M, NP1, DM}; pg8::F8Order S; S.init(G, bx);
              pg8::EpiProj E{QA, QB, QI, KI, GA, WI, 1.0f / 64.0f};
              FRESH_TID(tid2); pg8::gemm_phase<pg8::EpiProj, pg8::F8Order, 0, true>(lds, g, S, E, tid2); }
            { pg8::Gemm g{(const h16*)W1F8, (const h16*)H8, NP1, M, DM}; pg8::VtOrder S; S.init(G, bx);
              pg8::EpiVT E{VT8, 1.0f / 64.0f};
              FRESH_TID(tid3); pg8::gemm_phase<pg8::EpiVT, pg8::VtOrder, 0, true>(lds, g, S, E, tid3); }
            if (idx_last) {
                int bx2 = blockIdx.x; asm volatile("" : "+s"(bx2)); int G2 = gridDim.x; asm volatile("" : "+s"(G2));
                pg8::Gemm g{H16, W1T, M, NP1, DM}; pg8::IdxOrder S; S.init(G2, bx2);
                pg8::EpiProj E{QA, QB, QI, KI, GA, WI, 1.0f};
                FRESH_TID(tid4); pg8::gemm_phase<pg8::EpiProj, pg8::IdxOrder, 0, false>(lds, g, S, E, tid4); }
        }
        SEAM(P + 1);

        if (IN(P + 2)) PH_REP(2) {
            PH_ENTER();
            const float* rel_bias = KA_IN(ka, 11);
            PH_REP(10) for (int u0 = bx; u0 < 768; u0 += G) {
                const int u = (u0 & 7) * 96 + (u0 >> 3);
                const int b = u / 192, rem = u - b * 192, g = rem >> 6, rem2 = rem & 63, hh = rem2 >> 4, xx = rem2 & 15;
                const int dil = g == 0 ? 1 : (g == 1 ? 4 : 16), nblk = 16 / dil, res = xx / nblk, blk = xx - res * nblk;
                __syncthreads();
                { LAS float* tabw = (LAS float*)(lds + att::OFF_TAB);
                  for (int i = tid; i < att::TABA_N; i += NTHREADS) { const int dist = att::TABA_DMAX - i;
                      tabw[i] = (dist >= 0 && dist <= 128) ? rel_bias[t5_bucket(dist * dil) * 20 + g * 4 + hh] * LOG2E : 0.f; } }
                att::UnitA U; const size_t base = ((size_t)b * SEQ + res) * WIDTH_A + g * 512 + hh * 128;
                U.pitch = (size_t)dil * WIDTH_A; U.opitch = U.pitch; U.q0 = 256 * blk;
                U.K = nullptr; U.Q = nullptr; U.K8 = (const unsigned char*)KA + base; U.Q8 = (const unsigned char*)QA + base + (size_t)U.q0 * U.pitch; U.V = VA + base; U.O = OA + base + (size_t)U.q0 * U.pitch;
                U.lse = LSE + ((size_t)b * SEQ + res + (size_t)U.q0 * dil) * 12 + g * 4 + hh; U.lse_pitch = dil * 12;
                U.t_lo = blk == 0 ? 0 : 4 * blk - 2; U.t_hi = 4 * blk + 4;
                att::attn_unit<0>(lds, U, nullptr, 0.f, tid);
            }
            __syncthreads();
            {
                LAS float* wT = (LAS float*)lds;
                float wnx[4]; h16x8 knx[4]; bool have_nx = false;
                auto i1_item = [&](auto tln_c, const int u, const int qs, const int kh, const int tl0, const int unext) {
                    constexpr int TLN = decltype(tln_c)::value;
                    int tid_u = tid; asm volatile("" : "+v"(tid_u));
                    const int lane_u = tid_u & 63, r32 = lane_u & 31, hi = lane_u >> 5;
                    const int b = u / 272; int rem = u - b * 272, i = 0;
                    { int p = 0; for (;;) { const int c = (i >> 1) + 1; if (rem < p + c) break; p += c; ++i; } rem -= p; }
                    const int j = rem;
                    float wpre[4]; h16x8 kpre[4];
                    if (have_nx) {
#pragma unroll
                        for (int e4 = 0; e4 < 4; ++e4) { wpre[e4] = wnx[e4]; kpre[e4] = knx[e4]; }
                    } else { const float* wg = WI + ((size_t)b * SEQ + 128 * i) * 16; const h16* kg = KI + ((size_t)b * SEQ + 256 * j) * 64;
#pragma unroll
                      for (int e4 = 0; e4 < 4; ++e4) { const int e = tid_u + NTHREADS * e4; wpre[e4] = wg[e]; kpre[e4] = *(const h16x8*)(kg + (size_t)(e >> 3) * 64 + (e & 7) * 8); } }
#define I1_PREFETCH() do { have_nx = unext >= 0; if (have_nx) { const int bn = unext / 272; int remn = unext - bn * 272, in_ = 0; { int p = 0; for (;;) { const int c = (in_ >> 1) + 1; if (remn < p + c) break; p += c; ++in_; } remn -= p; } \
                        const float* wg = WI + ((size_t)bn * SEQ + 128 * in_) * 16; const h16* kg = KI + ((size_t)bn * SEQ + 256 * remn) * 64; int tp_ = tid; asm volatile("" : "+v"(tp_)); \
                        _Pragma("unroll") for (int e4 = 0; e4 < 4; ++e4) { const int e = tp_ + NTHREADS * e4; wnx[e4] = wg[e]; knx[e4] = *(const h16x8*)(kg + (size_t)(e >> 3) * 64 + (e & 7) * 8); } } \
                        else { _Pragma("unroll") for (int e4 = 0; e4 < 4; ++e4) { wnx[e4] = 0.f; knx[e4] = (h16x8){0, 0, 0, 0, 0, 0, 0, 0}; } } } while (0)
                    __syncthreads();
#pragma unroll
                    for (int e4 = 0; e4 < 4; ++e4) { const int e = tid_u + NTHREADS * e4; wT[(e & 15) * 128 + (e >> 4)] = wpre[e4] * 0.03125f;
                        *(LAS h16x8*)(lds + 8192 + (e >> 3) * 144 + (e & 7) * 16) = kpre[e4]; }
                    __syncthreads();
                    if (2 * j + kh <= i) {
                    const size_t tok0 = (size_t)b * SEQ + 128 * i + 32 * qs;
                    const LAS unsigned char* kl = lds + 8192 + (128 * kh + 32 * tl0 + r32) * 144 + hi * 16;
                    f32x16 acc[TLN];
                    const char* qbase = (const char*)(QI + tok0 * 1024); const unsigned qoff = (unsigned)(r32 * 1024 + 8 * hi) * 2u;
                    h16x8 afA[4], afB[4];
                    h16x8 kf[TLN][4];
#pragma unroll
                    for (int tl = 0; tl < TLN; ++tl)
#pragma unroll
                        for (int ks = 0; ks < 4; ++ks) kf[tl][ks] = *(const LAS h16x8*)(kl + (32 * tl) * 144 + 32 * ks);
#define I1_LOAD(dst, h_) do { unsigned vo_ = qoff; const char* qb_ = qbase + (size_t)(128 * (h_)); asm volatile("" : "+v"(vo_), "+s"(qb_)); \
                        _Pragma("unroll") for (int ks = 0; ks < 4; ++ks) dst[ks] = *(const h16x8*)(qb_ + vo_ + 32 * ks); } while (0)
#define I1_HEAD(af, h_, FIRST) do { const float wq_ = wT[(h_) * 128 + 32 * qs + r32]; \
                        _Pragma("unroll") for (int tl = 0; tl < TLN; ++tl) { f32x16 d; \
                            _Pragma("unroll") for (int r = 0; r < 16; ++r) d[r] = 0.f; \
                            _Pragma("unroll") for (int ks = 0; ks < 4; ++ks) d = __builtin_amdgcn_mfma_f32_32x32x16_f16(kf[tl][ks], af[ks], d, 0, 0, 0); \
                            _Pragma("unroll") for (int r = 0; r < 16; ++r) acc[tl][r] = (FIRST) ? I1_RELU(d[r]) * wq_ : fmaf(I1_RELU(d[r]), wq_, acc[tl][r]); } } while (0)
                    I1_LOAD(afA, 0);
                    I1_LOAD(afB, 1);
                    I1_HEAD(afA, 0, true);
                    I1_LOAD(afA, 2);
                    I1_HEAD(afB, 1, false);
#pragma unroll 1
                    for (int h = 2; h < 16; h += 2) {
                        I1_LOAD(afB, h + 1);
                        I1_HEAD(afA, h, false);
                        if (h + 2 < 16) I1_LOAD(afA, h + 2);
                        I1_HEAD(afB, h + 1, false);
                    }
#undef I1_LOAD
#undef I1_HEAD
                    I1_PREFETCH();
                    const int Li = 128 * (i + 1);
                    int zs_ = 0; asm volatile("" : "+v"(zs_)); const int lane_s = (int)__builtin_amdgcn_mbcnt_hi(~0u, __builtin_amdgcn_mbcnt_lo(~0u, (unsigned)zs_)), r32s = lane_s & 31, his = lane_s >> 5;
                    unsigned short* sp = SC + ((size_t)b * 528 + (size_t)(i * (i + 1) / 2)) * 16384 + (size_t)(32 * qs + r32s) * Li + 256 * j + 128 * kh + 32 * tl0 + 8 * his;
#pragma unroll
                    for (int tl = 0; tl < TLN; ++tl)
#pragma unroll
                        for (int pg = 0; pg < 2; ++pg) { const int g = 2 * pg;
                            const unsigned a0 = pkh(acc[tl][4 * g], acc[tl][4 * g + 1]), a1 = pkh(acc[tl][4 * g + 2], acc[tl][4 * g + 3]), b0 = pkh(acc[tl][4 * g + 4], acc[tl][4 * g + 5]), b1 = pkh(acc[tl][4 * g + 6], acc[tl][4 * g + 7]);
                            const auto s0 = __builtin_amdgcn_permlane32_swap(a0, b0, false, false), s1 = __builtin_amdgcn_permlane32_swap(a1, b1, false, false);
                            *(u32x4*)(sp + 32 * tl + 16 * pg) = (u32x4){s0[0], s1[0], s0[1], s1[1]}; }
                    } else { I1_PREFETCH(); }
#undef I1_PREFETCH
                };
                PH_REP(11) { const int nfull = G == 256 ? 1024 : 1088;
                    const int uq = G == 256 ? (bx & 7) * 136 + 128 + (bx >> 5) : -1;
                    for (int u0 = bx; u0 < nfull; u0 += G) { const int un = u0 + G; i1_item(IC<4>{}, (u0 & 7) * 136 + (u0 >> 3), wave & 3, wave >> 2, 0, un < nfull ? (un & 7) * 136 + (un >> 3) : uq); }
                    if (G == 256) i1_item(IC<1>{}, uq, (bx >> 3) & 3, wave >> 2, wave & 3, -1); }
            }
        }
        SEAM(P + 2);

        if (IN(P + 3)) PH_REP(3) {
            PH_ENTER();
            PH_REP(12) for (int it = gw; it < M; it += NGW) {
                const int b = it >> 12, t0_ = it & 4095, t = t0_ < 2048 ? t0_ : 6143 - t0_, rw = (b << 12) + t, i = t >> 7, rr = t & 127, n = t + 1, nj = (n + 63) >> 6;
                const unsigned short* row = SC + ((size_t)b * 528 + (size_t)(i * (i + 1) / 2)) * 16384 + (size_t)rr * (128 * (i + 1));
                unsigned mlo = 0u, mhi = 0u;
#define TK_PUT(j, bl) do { const bool me_ = lane == (j); mlo = me_ ? (unsigned)(bl) : mlo; mhi = me_ ? (unsigned)((bl) >> 32) : mhi; asm volatile("" : "+v"(mlo), "+v"(mhi)); } while (0)
                if (n <= TOPK) {
#pragma unroll
                    for (int j = 0; j < 4; ++j) { const unsigned long long bl = __ballot(64 * j + lane < n); TK_PUT(j, bl); }
                } else {
                    unsigned uk[64];
#pragma unroll
                    for (int j = 0; j < 64; ++j) uk[j] = 0u;
#pragma unroll
                    for (int g8 = 0; g8 < 8; ++g8) if (8 * g8 < nj) {
#pragma unroll
                        for (int jj = 0; jj < 8; ++jj) { const int k = 64 * (8 * g8 + jj) + lane; uk[8 * g8 + jj] = (unsigned)row[k < n ? k : n - 1]; } }
#pragma unroll
                    for (int g8 = 0; g8 < 8; ++g8) if (8 * g8 < nj) {
#pragma unroll
                        for (int jj = 0; jj < 8; ++jj) { const int j = 8 * g8 + jj, k = 64 * j + lane;
                            unsigned bits = uk[j]; if (bits == 0x8000u) bits = 0u;
                            const unsigned key = (bits & 0x8000u) ? (~bits & 0xffffu) : (bits | 0x8000u); uk[j] = k < n ? key : 0u; } }
                    unsigned T = 0u; bool exact = false;
                    for (int bit = 15; bit >= 0; --bit) {
                        const unsigned cand = T | (1u << bit); int cl = 0;
#pragma unroll
                        for (int g8 = 0; g8 < 8; ++g8) if (8 * g8 < nj) {
#pragma unroll
                            for (int jj = 0; jj < 8; ++jj) cl += (uk[8 * g8 + jj] >= cand) ? 1 : 0; }
                        const int c = wave_sum_dpp(cl);
                        if (c >= TOPK) { T = cand; if (c == TOPK) { exact = true; break; } }
                    }
                    if (exact) {
#pragma unroll
                        for (int g8 = 0; g8 < 8; ++g8) if (8 * g8 < nj) {
#pragma unroll
                            for (int jj = 0; jj < 8; ++jj) { const unsigned long long bs = __ballot(uk[8 * g8 + jj] >= T); TK_PUT(8 * g8 + jj, bs); } }
                    } else {
                        int cgl = 0;
#pragma unroll
                        for (int g8 = 0; g8 < 8; ++g8) if (8 * g8 < nj) {
#pragma unroll
                            for (int jj = 0; jj < 8; ++jj) cgl += (uk[8 * g8 + jj] > T) ? 1 : 0; }
                        const int need = TOPK - wave_sum_dpp(cgl); int tb = 0;
#pragma unroll
                        for (int g8 = 0; g8 < 8; ++g8) if (8 * g8 < nj) {
#pragma unroll
                            for (int jj = 0; jj < 8; ++jj) { const int j = 8 * g8 + jj;
                                const bool eq = uk[j] == T; const unsigned long long be = __ballot(eq);
                                const int rank = tb + __builtin_amdgcn_mbcnt_hi((unsigned)(be >> 32), __builtin_amdgcn_mbcnt_lo((unsigned)be, 0u));
                                const bool sel = (uk[j] > T) || (eq && rank < need);
                                const unsigned long long bs = __ballot(sel); TK_PUT(j, bs);
                                tb += __popcll(be); } }
                    }
                }
#undef TK_PUT
                *(u32x2*)(MASK + (size_t)rw * 64 + lane) = (u32x2){mlo, mhi};
            }
            PH_REP(13) for (int rw0 = gw; rw0 < M; rw0 += 2 * NGW) {
                const int hh = lane >> 4, dd = (lane & 15) * 8;
                int rws[2]; rws[0] = rw0; rws[1] = (rw0 + NGW < M) ? rw0 + NGW : rw0;
                float lq[2][3]; u32x4 oq[2][3];
#pragma unroll
                for (int q = 0; q < 2; ++q) { const float* lp = LSE + (size_t)rws[q] * 12 + hh; lq[q][0] = lp[0]; lq[q][1] = lp[4]; lq[q][2] = lp[8];
                    const h16* op = OA + (size_t)rws[q] * WIDTH_A + hh * 128 + dd; oq[q][0] = *(const u32x4*)(op); oq[q][1] = *(const u32x4*)(op + 512); oq[q][2] = *(const u32x4*)(op + 1024); }
#pragma unroll
                for (int q = 0; q < 2; ++q) {
                    const float mx = fmaxf(lq[q][0], fmaxf(lq[q][1], lq[q][2]));
                    float w0 = __builtin_amdgcn_exp2f(lq[q][0] - mx), w1 = __builtin_amdgcn_exp2f(lq[q][1] - mx), w2 = __builtin_amdgcn_exp2f(lq[q][2] - mx);
                    const float inv = 1.0f / (w0 + w1 + w2); w0 *= inv; w1 *= inv; w2 *= inv;
                    f32x4 a0, a1, b0, b1, c0, c1;
                    pg8::unpack8h(oq[q][0], a0, a1); pg8::unpack8h(oq[q][1], b0, b1); pg8::unpack8h(oq[q][2], c0, c1);
                    const f32x4 y0 = a0 * w0 + b0 * w1 + c0 * w2, y1 = a1 * w0 + b1 * w1 + c1 * w2;
                    *(u32x2*)(YY8 + (size_t)rws[q] * 1536 + hh * 128 + dd) = (u32x2){pkf8(y0.x * 16.f, y0.y * 16.f, y0.z * 16.f, y0.w * 16.f), pkf8(y1.x * 16.f, y1.y * 16.f, y1.z * 16.f, y1.w * 16.f)};
                }
            }
        }
        SEAM(P + 3);

        if (IN(P + 4)) PH_REP(4) {
            PH_ENTER();
            const float* rel_bias = KA_IN(ka, 11);
            for (int pu = bx; pu < 256; pu += G) {
                const int xcd_ = pu & 7, slot_ = pu >> 3, bh = 8 * (slot_ >> 3) + xcd_, pr = slot_ & 7, b = bh >> 3, h = bh & 7;
                for (int pass = 0; pass < 2; ++pass) {
                    const int qb = pass == 0 ? 15 - pr : pr;
                    __syncthreads();
                    { LAS float* tabw = (LAS float*)(lds + att::OFF_TAB);
                      for (int i = tid; i < att::TABB_N; i += NTHREADS) { const int dist = att::TABB_DMAX - i;
                          tabw[i] = dist >= 0 ? rel_bias[t5_bucket(dist) * 20 + 12 + h] * LOG2E : 0.f; } }
                    att::UnitA U; const size_t base = (size_t)b * SEQ * WIDTH_B + h * 128;
                    U.pitch = WIDTH_B; U.opitch = 1536; U.q0 = 256 * qb;
                    U.K = nullptr; U.Q = nullptr; U.K8 = (const unsigned char*)KB + base; U.Q8 = (const unsigned char*)QB + base + (size_t)U.q0 * WIDTH_B; U.V = nullptr; U.V8 = VT8 + (size_t)(b * 8 + h) * (64 * 8192); U.O = (h16*)(YY8 + ((size_t)b * SEQ + U.q0) * 1536 + 512 + h * 128);
                    U.lse = nullptr; U.lse_pitch = 0; U.t_lo = 0; U.t_hi = 4 * qb + 4;
                    att::attn_unit<1>(lds, U, MASK + (size_t)b * SEQ * 64, rel_bias[31 * 20 + 12 + h] * LOG2E, tid);
                }
            }
            __syncthreads();
        }
        SEAM(P + 4);

        if (IN(P + 5)) PH_REP(5) {
            PH_ENTER();
            pg8::Gemm g{(const h16*)YY8, (const h16*)WAB8, M, DM, 1536}; pg8::StaticOrder S; S.init(M, DM, G, bx); pg8::EpiMerge E{GA, GB, MG8};
            pg8::gemm_phase<pg8::EpiMerge, pg8::StaticOrder, 4, true>(lds, g, S, E, tid);
        }
        SEAM(P + 5);

        if (IN(P + 6)) PH_REP(6) {
            PH_ENTER();
            pg8::Gemm g{(const h16*)MG8, (const h16*)WO8, M, DM, DM}; pg8::StaticOrder S; S.init(M, DM, G, bx); pg8::EpiResid E{XS, XS, 1.0f / 1024.0f};
            pg8::gemm_phase<pg8::EpiResid, pg8::StaticOrder, 0, true>(lds, g, S, E, tid);
        }
        SEAM(P + 6);

        if (IN(P + 7)) PH_REP(7) {
            PH_ENTER();
            const float* g_ffn = KA_IN(ka, 9) + (size_t)layer * DM;
            rms_rows_h16<false>(XS, g_ffn, H16, nullptr, gw, NGW, lane);
        }
        SEAM(P + 7);

        if (IN(P + 8)) PH_REP(8) {
            PH_ENTER();
            pg8::Gemm g{H16, WGUT, M, NGU, DM}; pg8::StaticOrder S; S.init(M, NGU, G, bx); pg8::EpiSwiglu<F8_DOWN(layer)> E{HID};
            pg8::gemm_phase<pg8::EpiSwiglu<F8_DOWN(layer)>, pg8::StaticOrder>(lds, g, S, E, tid);
        }
        SEAM(P + 8);

        if (IN(P + 9)) PH_REP(9) {
            PH_ENTER();
            pg8::Gemm g{HID, WDT, M, DM, DFF}; pg8::StaticOrder S; S.init(M, DM, G, bx); pg8::EpiResid E{XS, layer + 1 < DEPTH ? XS : XF, F8_DOWN(layer) ? 1.0f / 512.0f : 1.0f};
            pg8::gemm_phase<pg8::EpiResid, pg8::StaticOrder, 0, F8_DOWN(layer)>(lds, g, S, E, tid);
        }
        SEAM(P + 9);
        }

    if (IN(20)) {
        PH_ENTER();
        const float* g_fin = KA_IN(ka, 10); float* outp = KA_OUT(ka); const h16* xf = XF;
        f32x4 ga[4], gb[4];
#pragma unroll
        for (int j = 0; j < 4; ++j) { ga[j] = *(const f32x4*)(g_fin + 8 * (lane + 64 * j)); gb[j] = *(const f32x4*)(g_fin + 8 * (lane + 64 * j) + 4); }
        for (int m0 = gw; m0 < M; m0 += 2 * NGW) {
            const int m1 = (m0 + NGW < M) ? m0 + NGW : m0;
            u32x4 r0[4], r1[4];
#pragma unroll
            for (int j = 0; j < 4; ++j) { r0[j] = *((const u32x4*)(xf + (size_t)m0 * DM) + lane + 64 * j); r1[j] = *((const u32x4*)(xf + (size_t)m1 * DM) + lane + 64 * j); }
            f32x4 va[4], vb[4], wa[4], wb[4]; float s0 = 0.f, s1 = 0.f;
#pragma unroll
            for (int j = 0; j < 4; ++j) { pg8::unpack8h(r0[j], va[j], vb[j]); pg8::unpack8h(r1[j], wa[j], wb[j]);
                s0 += (va[j].x * va[j].x + va[j].y * va[j].y) + (va[j].z * va[j].z + va[j].w * va[j].w) + (vb[j].x * vb[j].x + vb[j].y * vb[j].y) + (vb[j].z * vb[j].z + vb[j].w * vb[j].w);
                s1 += (wa[j].x * wa[j].x + wa[j].y * wa[j].y) + (wa[j].z * wa[j].z + wa[j].w * wa[j].w) + (wb[j].x * wb[j].x + wb[j].y * wb[j].y) + (wb[j].z * wb[j].z + wb[j].w * wb[j].w); }
            const float q0 = 1.0f / sqrtf(wave_sum(s0) * (1.0f / DM) + RMS_EPS), q1 = 1.0f / sqrtf(wave_sum(s1) * (1.0f / DM) + RMS_EPS);
            float* o0 = outp + (size_t)m0 * DM; float* o1 = outp + (size_t)m1 * DM;
#pragma unroll
            for (int j = 0; j < 4; ++j) { *(f32x4*)(o0 + 8 * (lane + 64 * j)) = va[j] * q0 * ga[j]; *(f32x4*)(o0 + 8 * (lane + 64 * j) + 4) = vb[j] * q0 * gb[j];
                                          *(f32x4*)(o1 + 8 * (lane + 64 * j)) = wa[j] * q1 * ga[j]; *(f32x4*)(o1 + 8 * (lane + 64 * j) + 4) = wb[j] * q1 * gb[j]; }
        }
    }
#undef IN
#undef SEAM
}

extern "C" void kernel_launch(void* const* d_in, const int* in_sizes, int n_in, void* d_out, int out_size, void* d_ws, size_t ws_size, hipStream_t stream) {
    static int grid = 0;
    if (grid == 0) {
        if (n_in != 12 || in_sizes[0] != M * DM || out_size != M * DM || ws_size < WS_END) {
            fprintf(stderr, "kernel_launch: unexpected shapes / workspace (n_in %d, in0 %d, out %d, ws %zu, need %zu); nothing launched\n", n_in, n_in > 0 ? in_sizes[0] : -1, out_size, ws_size, (size_t)WS_END);
            grid = -1; return; }
        int dev = 0, cus = 0, per_cu = 0;
        if (hipGetDevice(&dev) != hipSuccess || hipDeviceGetAttribute(&cus, hipDeviceAttributeMultiprocessorCount, dev) != hipSuccess) { grid = -1; return; }
        if (hipFuncSetAttribute((const void*)fwd_kernel, hipFuncAttributeMaxDynamicSharedMemorySize, LDS_BYTES) != hipSuccess) { fprintf(stderr, "kernel_launch: hipFuncSetAttribute failed\n"); grid = -1; return; }
        if (hipOccupancyMaxActiveBlocksPerMultiprocessor(&per_cu, (const void*)fwd_kernel, NTHREADS, LDS_BYTES) != hipSuccess || per_cu < 1)
            fprintf(stderr, "kernel_launch: note: occupancy query reports %d workgroups per CU\n", per_cu);
        (void)hipGetLastError();
        grid = cus;
    }
    if (grid < 0) return;
    if (hipMemsetAsync((char*)d_ws + WS_CTL, 0, CTL_ZERO_BYTES, stream) != hipSuccess) return;
    Args a{};
    for (int i = 0; i < 12; ++i) a.in[i] = (const float*)d_in[i];
    a.out = (float*)d_out; a.ws = (unsigned char*)d_ws;
#if MK_PER_PHASE_LAUNCH
    for (int p = 0; p <= 20; ++p) { a.ph_lo = p; a.ph_hi = p + 1; hipLaunchKernelGGL(fwd_kernel, dim3(grid), dim3(NTHREADS), LDS_BYTES, stream, a); }
#else
    a.ph_lo = 0; a.ph_hi = 21;
    hipLaunchKernelGGL(fwd_kernel, dim3(grid), dim3(NTHREADS), LDS_BYTES, stream, a);
#endif
    const hipError_t le = hipPeekAtLastError();
    if (le != hipSuccess) fprintf(stderr, "kernel_launch: launch failed: %s\n", hipGetErrorName(le));
}
```

```cpp
#include <hip/hip_runtime.h>
#include <cstdio>
#include <cstdint>

#ifndef MK_PER_PHASE_LAUNCH
#define MK_PER_PHASE_LAUNCH 0
#endif

#ifndef PROBE_MASK
#define PROBE_MASK 0
#endif
#ifndef F8_DOWN_MASK
#define F8_DOWN_MASK 2
#endif
#define F8_DOWN(l) (((F8_DOWN_MASK) >> (l)) & 1)
#define PH_REP(k) _Pragma("unroll 1") for (int rep_ = 0; rep_ < 1 + ((PROBE_MASK >> (k)) & 1); ++rep_)
#define LAS __attribute__((address_space(3)))
#define GAS __attribute__((address_space(1)))
typedef _Float16 h16;
typedef _Float16 h16x8 __attribute__((ext_vector_type(8)));
typedef _Float16 h16x4 __attribute__((ext_vector_type(4)));
typedef _Float16 h16x2 __attribute__((ext_vector_type(2)));
typedef float f32x2 __attribute__((ext_vector_type(2)));
typedef float f32x4 __attribute__((ext_vector_type(4)));
typedef float f32x16 __attribute__((ext_vector_type(16)));
typedef unsigned u32x2 __attribute__((ext_vector_type(2)));
typedef unsigned u32x4 __attribute__((ext_vector_type(4)));
typedef short v4i16_t __attribute__((ext_vector_type(4)));
typedef int v4i32 __attribute__((ext_vector_type(4)));
typedef int v8i32 __attribute__((ext_vector_type(8)));
typedef GAS unsigned gu32;
template <int N> struct IC { static constexpr int value = N; };

constexpr int BATCH = 4, SEQ = 4096, DM = 2048, DEPTH = 2, M = BATCH * SEQ;
constexpr int WIDTH_A = 1536, WIDTH_B = 1024, NIDX = 16, IDXD = 64;
constexpr int DIN = 12880, NP1 = 13056;
constexpr int DFF = 5632, NGU = 2 * DFF;
constexpr int TOPK = 256;
constexpr float RMS_EPS = 1e-6f;
constexpr float LOG2E = 1.4426950408889634f;
constexpr float C2 = 0.08838834764831845f * LOG2E;

constexpr size_t MiB = 1u << 20;
constexpr size_t WS_CTL = 0, CTL_ZERO_BYTES = 32 * 1024;
constexpr size_t WS_W1 = 1 * MiB, WS_WA = 52 * MiB, WS_WB = 54 * MiB, WS_WO = 58 * MiB, WS_WGU = 66 * MiB, WS_WD = 110 * MiB;
constexpr size_t WS_H16 = 132 * MiB;
constexpr size_t WS_QA = 196 * MiB, WS_KA = 244 * MiB, WS_VA = 292 * MiB;
constexpr size_t WS_QB = 340 * MiB, WS_KB = 372 * MiB, WS_VB = 404 * MiB;
constexpr size_t WS_QI = 436 * MiB, WS_KI = 468 * MiB, WS_WI = 470 * MiB, WS_LSE = 471 * MiB;
constexpr size_t WS_GA = 472 * MiB, WS_GB = 536 * MiB;
constexpr size_t WS_X = 600 * MiB;
constexpr size_t WS_END = 776 * MiB;
constexpr int CW_BAR = 4096;

constexpr int RING_BYTES = 131072;
constexpr int LDSCTL_OFF = RING_BYTES, MISC_OFF = LDSCTL_OFF + 320;
constexpr int LDS_BYTES = 147456;
constexpr int NWAVES = 8, NTHREADS = 512;

__device__ __forceinline__ unsigned pkh(float lo, float hi) { f32x2 v = {lo, hi}; h16x2 b = __builtin_convertvector(v, h16x2); return __builtin_bit_cast(unsigned, b); }
__device__ __forceinline__ unsigned pkf8(float a, float b, float c, float d) { int w = __builtin_amdgcn_cvt_pk_fp8_f32(a, b, 0, false); w = __builtin_amdgcn_cvt_pk_fp8_f32(c, d, w, true); return (unsigned)w; }
__device__ __forceinline__ v8i32 cat8(h16x8 a, h16x8 b) { return __builtin_shufflevector(__builtin_bit_cast(v4i32, a), __builtin_bit_cast(v4i32, b), 0, 1, 2, 3, 4, 5, 6, 7); }
__device__ __forceinline__ float relu_imax(float x) { const int i = __float_as_int(x); return __int_as_float(i > 0 ? i : 0); }
#define I1_RELU(x) relu_imax(x)
__device__ __forceinline__ float sig255_(float x, float c1) { return __builtin_amdgcn_rcpf(fmaf(__builtin_amdgcn_exp2f(x * c1), 1.0f / 255.0f, 1.0f / 255.0f)); }
__device__ __forceinline__ float sigmoidf_(float x) { return __builtin_amdgcn_rcpf(1.0f + __builtin_amdgcn_exp2f(-x * LOG2E)); }
#define LDS_WAIT() asm volatile("s_waitcnt lgkmcnt(0)" ::: "memory")
#define VM_WAIT() asm volatile("s_waitcnt vmcnt(0)" ::: "memory")

namespace pg8 {
constexpr int BM = 256, BK = 64, HALF = 128, HTB = HALF * BK * 2, STAGE_BYTES = 8 * HTB, NXCD = 8, WGM = 8;
__host__ __device__ __forceinline__ int lds_byte(int r, int c) { const int st = (r >> 4) * 2 + (c >> 5), rr = r & 15, cc = c & 31, ob = rr * 64 + cc * 2; return st * 1024 + (ob ^ (((ob >> 9) & 1) << 5)); }
__host__ __device__ __forceinline__ void stage_rc(int b, int& R, int& C) { const int st = b / 1024, sb = b % 1024, swz = sb ^ (((sb >> 9) & 1) << 5); R = (st >> 1) * 16 + swz / 64; C = (st & 1) * 32 + (swz % 64) / 2; }
__host__ __device__ __forceinline__ int perm32(int rho) { const int n = rho >> 4, i = rho & 15; return 8 * (i >> 2) + 4 * n + (i & 3); }
struct Unit { int pm, pn; };
struct Gemm { const h16* A; const h16* Bt; int M, N, K; };
struct StaticOrder {
    int nM, nN, nwg, G, c;
    __host__ __device__ void init(int M_, int N_, int G_, int c_) { nM = M_ / BM; nN = N_ / BM; nwg = nM * nN; G = G_; c = c_; }
    __host__ __device__ bool next(int i, Unit& u) const {
        const long L = (long)i * G + c; if (L >= nwg) return false;
        int wgid = (int)L; { const int q = nwg / NXCD, r = nwg % NXCD, xcd = wgid % NXCD, off = wgid / NXCD; wgid = (xcd < r ? xcd * (q + 1) : r * (q + 1) + (xcd - r) * q) + off; }
        const int nig = WGM * nN, gid = wgid / nig, fm = gid * WGM, gsz = (nM - fm) < WGM ? (nM - fm) : WGM;
        u.pm = fm + ((wgid % nig) % gsz); u.pn = (wgid % nig) / gsz; return true;
    }
    __device__ __forceinline__ void a_ready(const Unit&) const {}
    __device__ __forceinline__ void done(const Unit&) const {}
};
struct IdxOrder {
    int x, cl, cpx;
    __host__ __device__ void init(int G_, int c_) { x = c_ % NXCD; cl = c_ / NXCD; cpx = G_ / NXCD; }
    __host__ __device__ bool next(int i, Unit& u) const { const int o = cl + i * cpx; if (o >= 40) return false; u.pm = 8 * x + (o & 7); u.pn = 30 + (o >> 3); return true; }
    __device__ __forceinline__ void a_ready(const Unit&) const {}
    __device__ __forceinline__ void done(const Unit&) const {}
};
struct F8Order {
    int x, cl, cpx;
    __host__ __device__ void init(int G_, int c_) { x = c_ % NXCD; cl = c_ / NXCD; cpx = G_ / NXCD; }
    __host__ __device__ bool next(int i, Unit& u) const {
        int o;
        if (cpx == 32) { if (i < 9) o = i * 32 + cl; else { if (cl < 8 || i >= 11) return false; o = 288 + (i - 9) * 24 + (cl - 8); } }
        else { o = cl + i * cpx; if (o >= 336) return false; }
        const int q = o >> 3; u.pm = 8 * x + (o & 7); u.pn = q < 26 ? q : q + 9; return true;
    }
    __device__ __forceinline__ void a_ready(const Unit&) const {}
    __device__ __forceinline__ void done(const Unit&) const {}
};
struct VtOrder {
    int x, cl, cpx;
    __host__ __device__ void init(int G_, int c_) { x = c_ % NXCD; cl = c_ / NXCD; cpx = G_ / NXCD; }
    __host__ __device__ bool next(int i, Unit& u) const { const int o = cl + i * cpx; if (o >= 32) return false; u.pm = 26 + (o >> 3); u.pn = 8 * x + (o & 7); return true; }
    __device__ __forceinline__ void a_ready(const Unit&) const {}
    __device__ __forceinline__ void done(const Unit&) const {}
};
template <class Epi, class Sched, int TMID = 0, bool F8 = false>
__device__ __forceinline__ void gemm_phase(LAS unsigned char* lds, const Gemm g, const Sched& S, const Epi& E, const int tid) {
    const int wid = __builtin_amdgcn_readfirstlane(tid >> 6), lane = tid & 63, wr = wid >> 2, wc = wid & 3, fr = lane & 15, fq = lane >> 4;
    const int K = g.K, RB = F8 ? K : 2 * K, nt = RB / 128;
    unsigned voffA[2], voffB[2];
#pragma unroll
    for (int i = 0; i < 2; ++i) { int R, C; stage_rc(tid * 16 + i * 8192, R, C); const int Rb = Epi::PERM ? ((R & ~31) + perm32(R & 31)) : R;
        voffA[i] = (unsigned)(R * RB + C * 2); voffB[i] = (unsigned)(Rb * RB + C * 2); }
    const size_t kstep = (size_t)(BK * 2);
    const size_t hstep = (size_t)HALF * RB;
    const size_t tstep = 2 * hstep;
    const unsigned ldsw = (unsigned)wid * 1024u;
    const int aoff = lds_byte(wr * 64 + fr, fq * 8); int boff = lds_byte(wc * 32 + fr, fq * 8) + 4 * HTB;
    asm volatile("" : "+v"(boff));
#define PG8_SA(b, h) (((b) * 2 + (h)) * HTB)
#define PG8_SB(b, h) ((4 + (b) * 2 + (h)) * HTB)
#define PG8_STAGE(bufoff, gbase, voff) do { if constexpr (F8) { unsigned vo_ = (voff)[0]; const char* g0_ = (const char*)(gbase); const char* g1_ = g0_ + 64 * RB; asm volatile("" : "+v"(vo_), "+s"(g0_), "+s"(g1_)); \
        __builtin_amdgcn_global_load_lds((const unsigned*)(g0_ + vo_), (LAS unsigned*)(lds + (bufoff) + ldsw), 16, 0, 0); __builtin_amdgcn_global_load_lds((const unsigned*)(g1_ + vo_), (LAS unsigned*)(lds + (bufoff) + ldsw + 8192), 16, 0, 0); } \
      else { _Pragma("unroll") for (int _i = 0; _i < 2; ++_i) \
        __builtin_amdgcn_global_load_lds((const unsigned*)((const char*)(gbase) + (voff)[_i]), (LAS unsigned*)(lds + (bufoff) + ldsw + _i * 8192), 16, 0, 0); } } while (0)
#define PG8_LDA(dst, b, h) do { _Pragma("unroll") for (int m = 0; m < 4; ++m) _Pragma("unroll") for (int k = 0; k < 2; ++k) dst[m][k] = *(const LAS h16x8*)(lds + PG8_SA(b, h) + aoff + m * 2048 + k * 1024); } while (0)
#define PG8_LDB(dst, b, h) do { _Pragma("unroll") for (int n = 0; n < 2; ++n) _Pragma("unroll") for (int k = 0; k < 2; ++k) dst[n][k] = *(const LAS h16x8*)(lds + ((b) * 2 + (h)) * HTB + boff + n * 2048 + k * 1024); } while (0)
#define PG8_MMA(ai, bj, At, Bt) do { __builtin_amdgcn_s_setprio(1); _Pragma("unroll") for (int m = 0; m < 4; ++m) _Pragma("unroll") for (int n = 0; n < 2; ++n) { \
        if constexpr (F8) acc[ai][bj][m][n] = __builtin_amdgcn_mfma_scale_f32_16x16x128_f8f6f4(cat8(Bt[n][0], Bt[n][1]), cat8(At[m][0], At[m][1]), acc[ai][bj][m][n], 0, 0, 0, 0, 0, 0); \
        else { _Pragma("unroll") for (int k = 0; k < 2; ++k) acc[ai][bj][m][n] = __builtin_amdgcn_mfma_f32_16x16x32_f16(Bt[n][k], At[m][k], acc[ai][bj][m][n], 0, 0, 0); } } \
        __builtin_amdgcn_s_setprio(0); } while (0)
#define PG8_WAIT_V(n) asm volatile("s_waitcnt vmcnt(" #n ")" ::: "memory")
#define PG8_WAIT_L(n) asm volatile("s_waitcnt lgkmcnt(" #n ")" ::: "memory")
#define PG8_BAR __builtin_amdgcn_s_barrier()
#define PG8_SCHED __builtin_amdgcn_sched_barrier(0)
    Unit cur, nxt; int ui = 0;
    if (!S.next(0, cur)) return;
    f32x4 acc[2][2][4][2];
#pragma unroll
    for (int a = 0; a < 2; ++a)
#pragma unroll
        for (int b = 0; b < 2; ++b)
#pragma unroll
            for (int m = 0; m < 4; ++m)
#pragma unroll
                for (int n = 0; n < 2; ++n) acc[a][b][m][n] = (f32x4){0.f, 0.f, 0.f, 0.f};
    h16x8 At[4][2], B0[2][2], B1[2][2];
    const char* cA = (const char*)g.A + (size_t)cur.pm * tstep; const char* cB = (const char*)g.Bt + (size_t)cur.pn * tstep;
    S.a_ready(cur);
    PG8_STAGE(PG8_SB(0, 0), cB, voffB); PG8_STAGE(PG8_SB(0, 1), cB + hstep, voffB); PG8_STAGE(PG8_SA(0, 0), cA, voffA); PG8_STAGE(PG8_SA(0, 1), cA + hstep, voffA);
    if (wr == 1) PG8_BAR;
    PG8_WAIT_V(2); PG8_BAR;
    PG8_STAGE(PG8_SB(1, 0), cB + kstep, voffB); PG8_STAGE(PG8_SA(1, 0), cA + kstep, voffA); PG8_STAGE(PG8_SB(1, 1), cB + hstep + kstep, voffB);
    PG8_WAIT_V(6); PG8_BAR;
    for (;;) {
        const bool has_next = S.next(ui + 1, nxt);
        const char* nA = has_next ? (const char*)g.A + (size_t)nxt.pm * tstep : cA; const char* nB = has_next ? (const char*)g.Bt + (size_t)nxt.pn * tstep : cB;
        for (int t = 0; t < nt; t += 2) {
            const bool last = (t == nt - 2);
            const char* a1 = cA + (size_t)(t + 1) * kstep;
            const char* a2 = last ? nA : cA + (size_t)(t + 2) * kstep; const char* b2 = last ? nB : cB + (size_t)(t + 2) * kstep;
            const char* a3 = a2 + kstep; const char* b3 = b2 + kstep;
            if (last && has_next) S.a_ready(nxt);
            if constexpr (TMID != 0) { if (t == TMID) { E.mid(acc, cur, wr, wc, fr, fq); PG8_SCHED; } }
            PG8_LDB(B0, 0, 0); PG8_LDB(B1, 0, 1); PG8_SCHED; PG8_LDA(At, 0, 0); PG8_STAGE(PG8_SA(1, 1), a1 + hstep, voffA);
            PG8_WAIT_V(8); PG8_WAIT_L(0); PG8_BAR; PG8_MMA(0, 0, At, B0); PG8_MMA(0, 1, At, B1); PG8_BAR; PG8_SCHED;
            PG8_LDA(At, 0, 1); PG8_STAGE(PG8_SB(0, 0), b2, voffB); PG8_STAGE(PG8_SB(0, 1), b2 + hstep, voffB); PG8_STAGE(PG8_SA(0, 0), a2, voffA);
            PG8_WAIT_V(8); PG8_WAIT_L(0); PG8_BAR; PG8_MMA(1, 0, At, B0); PG8_MMA(1, 1, At, B1); PG8_BAR; PG8_SCHED;
            PG8_LDB(B0, 1, 0); PG8_LDB(B1, 1, 1); PG8_SCHED; PG8_LDA(At, 1, 0); PG8_STAGE(PG8_SA(0, 1), a2 + hstep, voffA);
            PG8_WAIT_V(8); PG8_WAIT_L(0); PG8_BAR; PG8_MMA(0, 0, At, B0); PG8_MMA(0, 1, At, B1); PG8_BAR; PG8_SCHED;
            PG8_LDA(At, 1, 1); PG8_STAGE(PG8_SB(1, 0), b3, voffB); PG8_STAGE(PG8_SB(1, 1), b3 + hstep, voffB); PG8_STAGE(PG8_SA(1, 0), a3, voffA);
            PG8_WAIT_V(8); PG8_WAIT_L(0); PG8_BAR; PG8_MMA(1, 0, At, B0); PG8_MMA(1, 1, At, B1); PG8_BAR; PG8_SCHED;
        }
        if (wr == 0) PG8_BAR;
        E(acc, cur, wr, wc, fr, fq); S.done(cur);
        if (!has_next) break;
#pragma unroll
        for (int a = 0; a < 2; ++a)
#pragma unroll
            for (int b = 0; b < 2; ++b)
#pragma unroll
                for (int m = 0; m < 4; ++m)
#pragma unroll
                    for (int n = 0; n < 2; ++n) acc[a][b][m][n] = (f32x4){0.f, 0.f, 0.f, 0.f};
        cur = nxt; cA = nA; cB = nB; ++ui;
        if (wr == 1) PG8_BAR;
    }
    PG8_WAIT_V(0);
    PG8_BAR;
#undef PG8_SA
#undef PG8_SB
#undef PG8_STAGE
#undef PG8_LDA
#undef PG8_LDB
#undef PG8_MMA
#undef PG8_WAIT_V
#undef PG8_WAIT_L
#undef PG8_BAR
#undef PG8_SCHED
}

__device__ __forceinline__ u32x4 pack8h(f32x4 a, f32x4 b) { u32x4 w; w.x = pkh(a[0], a[1]); w.y = pkh(a[2], a[3]); w.z = pkh(b[0], b[1]); w.w = pkh(b[2], b[3]); return w; }
__device__ __forceinline__ void unpack8h(u32x4 w, f32x4& a, f32x4& b) {
    const h16x8 h = __builtin_bit_cast(h16x8, w);
    a = (f32x4){(float)h[0], (float)h[1], (float)h[2], (float)h[3]}; b = (f32x4){(float)h[4], (float)h[5], (float)h[6], (float)h[7]};
}
struct EpiProj {
    static constexpr bool PERM = true;
    h16 *QA, *QB, *QI, *KI; unsigned char* G8; float* WI; float osc;
    __device__ __forceinline__ void operator()(const f32x4 (&acc)[2][2][4][2], const Unit& u, int wr, int wc, int fr, int fq) const {
        { int z_ = 0; asm volatile("" : "+v"(z_)); const int ln_ = (int)__builtin_amdgcn_mbcnt_hi(~0u, __builtin_amdgcn_mbcnt_lo(~0u, (unsigned)z_)); fr = ln_ & 15; fq = ln_ >> 4; }
        const int pn = u.pn; const int row0 = u.pm * BM + wr * 64 + fr, colw = wc * 32 + 8 * fq;
        if (pn == 34) {
#pragma unroll
            for (int ai = 0; ai < 2; ++ai)
#pragma unroll
                for (int m = 0; m < 4; ++m) { const size_t row = (size_t)(row0 + ai * HALF + m * 16);
                    if (wc < 2) *(u32x4*)(KI + row * 64 + colw) = pack8h(acc[ai][0][m][0] * osc, acc[ai][0][m][1] * osc);
                    else if (wc == 2 && fq < 2) { *(f32x4*)(WI + row * 16 + 8 * fq) = acc[ai][0][m][0] * osc; *(f32x4*)(WI + row * 16 + 8 * fq + 4) = acc[ai][0][m][1] * osc; } }
            return;
        }
        if (pn >= 18 && pn < 26) {
            const int q = pn - 18, s = q >> 2; unsigned char* b8 = (unsigned char*)(QB + (size_t)s * M * WIDTH_B) + (q - 4 * s) * BM + colw;
#pragma unroll
            for (int ai = 0; ai < 2; ++ai)
#pragma unroll
                for (int m = 0; m < 4; ++m) { unsigned char* rowp = b8 + (size_t)(row0 + ai * HALF + m * 16) * WIDTH_B;
#pragma unroll
                    for (int bj = 0; bj < 2; ++bj) { const f32x4 v0 = acc[ai][bj][m][0] * osc, v1 = acc[ai][bj][m][1] * osc;
                        *(u32x2*)(rowp + bj * HALF) = (u32x2){pkf8(v0[0], v0[1], v0[2], v0[3]), pkf8(v1[0], v1[1], v1[2], v1[3])}; } }
            return; }
        if (pn < 12) {
            const int s = pn / 6; unsigned char* b8 = (unsigned char*)(QA + (size_t)s * M * WIDTH_A) + (pn - 6 * s) * BM + colw;
#pragma unroll
            for (int ai = 0; ai < 2; ++ai)
#pragma unroll
                for (int m = 0; m < 4; ++m) { unsigned char* rowp = b8 + (size_t)(row0 + ai * HALF + m * 16) * WIDTH_A;
#pragma unroll
                    for (int bj = 0; bj < 2; ++bj) { const f32x4 v0 = acc[ai][bj][m][0] * osc, v1 = acc[ai][bj][m][1] * osc;
                        *(u32x2*)(rowp + bj * HALF) = (u32x2){pkf8(v0[0], v0[1], v0[2], v0[3]), pkf8(v1[0], v1[1], v1[2], v1[3])}; } }
            return; }
        h16* base; int ldc, colt; bool sig = false;
        if (pn < 18) { const int s = pn / 6; base = QA + (size_t)s * M * WIDTH_A; ldc = WIDTH_A; colt = (pn - 6 * s) * BM; }
        else if (pn < 30) { const int q = pn - 18, s = q / 4; base = QB + (size_t)s * M * WIDTH_B; ldc = WIDTH_B; colt = (q - 4 * s) * BM; }
        else if (pn < 34) { base = QI; ldc = 1024; colt = (pn - 30) * BM; }
        else {
            const int q = pn - 35, s8 = q / 8; unsigned char* gb_ = G8 + (size_t)s8 * M * DM + (q - 8 * s8) * BM + colw;
            const float c1_ = -osc * LOG2E;
#pragma unroll
            for (int ai = 0; ai < 2; ++ai)
#pragma unroll
                for (int m = 0; m < 4; ++m) { unsigned char* rowp = gb_ + (size_t)(row0 + ai * HALF + m * 16) * DM;
#pragma unroll
                    for (int bj = 0; bj < 2; ++bj) { u32x2 w = {0u, 0u};
#pragma unroll
                        for (int e = 0; e < 4; ++e) { w.x = __builtin_amdgcn_cvt_pk_u8_f32(sig255_(acc[ai][bj][m][0][e], c1_), e, w.x); w.y = __builtin_amdgcn_cvt_pk_u8_f32(sig255_(acc[ai][bj][m][1][e], c1_), e, w.y); }
                        *(u32x2*)(rowp + bj * HALF) = w; } }
            return; }
#pragma unroll
        for (int ai = 0; ai < 2; ++ai)
#pragma unroll
            for (int m = 0; m < 4; ++m) { h16* rowp = base + (size_t)(row0 + ai * HALF + m * 16) * ldc + colt + colw;
#pragma unroll
                for (int bj = 0; bj < 2; ++bj) { f32x4 v0 = acc[ai][bj][m][0] * osc, v1 = acc[ai][bj][m][1] * osc;
                    if (sig) {
#pragma unroll
                        for (int e = 0; e < 4; ++e) { v0[e] = sigmoidf_(v0[e]); v1[e] = sigmoidf_(v1[e]); } }
                    *(u32x4*)(rowp + bj * HALF) = pack8h(v0, v1); } }
    }
};
struct EpiVT {
    static constexpr bool PERM = true;
    unsigned char* VT; float osc;
    __device__ __forceinline__ void operator()(const f32x4 (&acc)[2][2][4][2], const Unit& u, int wr, int wc, int fr, int fq) const {
        { int z_ = 0; asm volatile("" : "+v"(z_)); const int ln_ = (int)__builtin_amdgcn_mbcnt_hi(~0u, __builtin_amdgcn_mbcnt_lo(~0u, (unsigned)z_)); fr = ln_ & 15; fq = ln_ >> 4; }
        const int wt = u.pm - 26, tokt = u.pn, b = tokt >> 4;
#pragma unroll
        for (int ai = 0; ai < 2; ++ai) { const int bh = b * 8 + 2 * wt + ai;
#pragma unroll
            for (int m = 0; m < 4; ++m) { const int d = 64 * wr + 16 * m + fr;
#pragma unroll
                for (int bj = 0; bj < 2; ++bj) { const int t64 = 4 * (tokt & 15) + 2 * bj + (wc >> 1);
                    unsigned char* q = VT + ((size_t)((bh * 64 + t64) * 128 + d) * 64 + 16 * (wc & 1) + 4 * fq);
#pragma unroll
                    for (int n = 0; n < 2; ++n) { const f32x4 v = acc[ai][bj][m][n] * osc; *(unsigned*)(q + 32 * n) = pkf8(v[0], v[1], v[2], v[3]); } } } }
    }
};
struct EpiMerge {
    static constexpr bool PERM = true;
    const unsigned char* Ga; const unsigned char* Gb; unsigned char* Out;
    static __device__ __forceinline__ void unpk(u32x2 q, f32x4& g0, f32x4& g1) { const unsigned a_ = q.x, b_ = q.y;
        g0 = (f32x4){(float)(a_ & 0xffu), (float)((a_ >> 8) & 0xffu), (float)((a_ >> 16) & 0xffu), (float)(a_ >> 24)};
        g1 = (f32x4){(float)(b_ & 0xffu), (float)((b_ >> 8) & 0xffu), (float)((b_ >> 16) & 0xffu), (float)(b_ >> 24)}; }
    __device__ __forceinline__ void mid(f32x4 (&acc)[2][2][4][2], const Unit& u, int wr, int wc, int fr, int fq) const {
        int row0 = u.pm * BM + wr * 64 + fr, col0 = u.pn * BM + wc * 32 + 8 * fq;
        asm volatile("" : "+v"(row0), "+v"(col0));
#pragma unroll
        for (int ai = 0; ai < 2; ++ai) {
            u32x2 qa[4][2], qb[4][2];
#pragma unroll
            for (int m = 0; m < 4; ++m) { const size_t off = (size_t)(row0 + ai * HALF + m * 16) * DM + col0;
#pragma unroll
                for (int bj = 0; bj < 2; ++bj) { qa[m][bj] = *(const u32x2*)(Ga + off + bj * HALF); qb[m][bj] = *(const u32x2*)(Gb + off + bj * HALF); } }
#pragma unroll
            for (int m = 0; m < 4; ++m)
#pragma unroll
                for (int bj = 0; bj < 2; ++bj) { f32x4 a0, a1, b0, b1; unpk(qa[m][bj], a0, a1); unpk(qb[m][bj], b0, b1);
#pragma unroll
                    for (int e = 0; e < 4; ++e) { acc[ai][bj][m][0][e] *= a0[e] * __builtin_amdgcn_rcpf(fmaxf(b0[e], 0.5f)); acc[ai][bj][m][1][e] *= a1[e] * __builtin_amdgcn_rcpf(fmaxf(b1[e], 0.5f)); } }
            asm volatile("" ::: "memory"); }
    }
    __device__ __forceinline__ void operator()(const f32x4 (&acc)[2][2][4][2], const Unit& u, int wr, int wc, int fr, int fq) const {
        int row0 = u.pm * BM + wr * 64 + fr, col0 = u.pn * BM + wc * 32 + 8 * fq;
        asm volatile("" : "+v"(row0), "+v"(col0));
#pragma unroll
        for (int ai = 0; ai < 2; ++ai) {
            u32x2 qb[4][2];
#pragma unroll
            for (int m = 0; m < 4; ++m) { const size_t off = (size_t)(row0 + ai * HALF + m * 16) * DM + col0;
#pragma unroll
                for (int bj = 0; bj < 2; ++bj) qb[m][bj] = *(const u32x2*)(Gb + off + bj * HALF); }
#pragma unroll
            for (int m = 0; m < 4; ++m) { const size_t off = (size_t)(row0 + ai * HALF + m * 16) * DM + col0;
#pragma unroll
                for (int bj = 0; bj < 2; ++bj) { f32x4 b0, b1; unpk(qb[m][bj], b0, b1); f32x4 v0, v1;
#pragma unroll
                    for (int e = 0; e < 4; ++e) { v0[e] = acc[ai][bj][m][0][e] * (fmaxf(b0[e], 0.5f) * (1.0f / (255.0f * 32.0f))); v1[e] = acc[ai][bj][m][1][e] * (fmaxf(b1[e], 0.5f) * (1.0f / (255.0f * 32.0f))); }
                    *(u32x2*)(Out + off + bj * HALF) = (u32x2){pkf8(v0[0], v0[1], v0[2], v0[3]), pkf8(v1[0], v1[1], v1[2], v1[3])}; } }
            asm volatile("" ::: "memory"); }
    }
};
struct EpiResid {
    static constexpr bool PERM = true;
    const h16* base; h16* out; float osc;
    __device__ __forceinline__ void operator()(const f32x4 (&acc)[2][2][4][2], const Unit& u, int wr, int wc, int fr, int fq) const {
        const int row0 = u.pm * BM + wr * 64 + fr, col0 = u.pn * BM + wc * 32 + 8 * fq;
#pragma unroll
        for (int ai = 0; ai < 2; ++ai) {
            u32x4 bq[4][2];
#pragma unroll
            for (int m = 0; m < 4; ++m) { const size_t off = (size_t)(row0 + ai * HALF + m * 16) * DM + col0;
#pragma unroll
                for (int bj = 0; bj < 2; ++bj) bq[m][bj] = *(const u32x4*)(base + off + bj * HALF); }
#pragma unroll
            for (int m = 0; m < 4; ++m) { const size_t off = (size_t)(row0 + ai * HALF + m * 16) * DM + col0;
#pragma unroll
                for (int bj = 0; bj < 2; ++bj) { f32x4 b0, b1; unpack8h(bq[m][bj], b0, b1);
                    *(u32x4*)(out + off + bj * HALF) = pack8h(b0 + acc[ai][bj][m][0] * osc, b1 + acc[ai][bj][m][1] * osc); } }
            asm volatile("" ::: "memory"); }
    }
};
template <bool O8>
struct EpiSwiglu {
    static constexpr bool PERM = true;
    h16* HID;
    __device__ __forceinline__ void operator()(const f32x4 (&acc)[2][2][4][2], const Unit& u, int wr, int wc, int fr, int fq) const {
        const int row0 = u.pm * BM + wr * 64 + fr, col0 = u.pn * HALF + wc * 32 + 8 * fq;
#pragma unroll
        for (int ai = 0; ai < 2; ++ai)
#pragma unroll
            for (int m = 0; m < 4; ++m) { f32x4 o[2];
#pragma unroll
                for (int n = 0; n < 2; ++n)
#pragma unroll
                    for (int e = 0; e < 4; ++e) { const float gt = acc[ai][0][m][n][e], up = acc[ai][1][m][n][e]; o[n][e] = (gt * up) * __builtin_amdgcn_rcpf(1.0f + __builtin_amdgcn_exp2f(-gt)); }
                if (O8) *(u32x2*)((unsigned char*)HID + (size_t)(row0 + ai * HALF + m * 16) * DFF + col0) = (u32x2){pkf8(o[0][0] * 4.f, o[0][1] * 4.f, o[0][2] * 4.f, o[0][3] * 4.f), pkf8(o[1][0] * 4.f, o[1][1] * 4.f, o[1][2] * 4.f, o[1][3] * 4.f)};
                else __builtin_nontemporal_store(pack8h(o[0], o[1]), (u32x4*)(HID + (size_t)(row0 + ai * HALF + m * 16) * DFF + col0)); }
    }
};
}

#define XB_TMO      128
#define XB_XCNT(j)  (256  + 64 * (j))
#define XB_XSUB(j)  (1280 + 64 * (j))
#define XB_XGEN(j)  (2304 + 64 * (j))
#define XB_TOP      3328
#define XB_TOPGEN   3392
#define XCD_BAR_WORDS 3456
#define XB_SPIN_CAP (1u << 18)
static_assert((CW_BAR + XCD_BAR_WORDS) * 4 <= (int)CTL_ZERO_BYTES, "barrier words inside the per-call memset");
__device__ __forceinline__ unsigned xb_ld(unsigned* p)              { return __hip_atomic_load(p, __ATOMIC_RELAXED, __HIP_MEMORY_SCOPE_AGENT); }
__device__ __forceinline__ unsigned xb_add(unsigned* p, unsigned v) { return __hip_atomic_fetch_add(p, v, __ATOMIC_RELAXED, __HIP_MEMORY_SCOPE_AGENT); }
__device__ __forceinline__ unsigned xb_xcc_id() { return (unsigned)__builtin_amdgcn_s_getreg((3 << 11) | 20) & 0xFu; }
#define XB_SPIN(cond, bar) do { unsigned _sp = 0; while (cond) { __builtin_amdgcn_s_sleep(1); \
    if ((++_sp & 255u) == 0u) { if (xb_ld(&(bar)[XB_TMO])) break; if (_sp > XB_SPIN_CAP) { atomicAdd(&(bar)[XB_TMO], 1u); break; } } } } while (0)
struct XcdBarrier { unsigned* bar; unsigned x; volatile LAS unsigned* st; };
__device__ __forceinline__ XcdBarrier xcd_barrier_post(unsigned* bar, volatile LAS unsigned* st) {
    XcdBarrier b; b.bar = bar; b.x = xb_xcc_id(); b.st = st;
    if (threadIdx.x == 0) (void)xb_add(&bar[XB_XCNT(b.x)], 1u);
    return b;
}
__device__ __forceinline__ void xcd_barrier_complete(unsigned* bar, unsigned x, unsigned& nloc, unsigned& nx) {
    const unsigned G = gridDim.x * gridDim.y * gridDim.z;
    unsigned sum, cnt, mine, sp = 0u;
    for (;;) {
        sum = 0u; cnt = 0u; mine = 0u;
#pragma unroll 1
        for (unsigned j = 0; j < 16; ++j) { const unsigned c = xb_ld(&bar[XB_XCNT(j)]); sum += c; cnt += (c > 0u) ? 1u : 0u; mine = (j == x) ? c : mine; }
        if (sum == G) break;
        __builtin_amdgcn_s_sleep(1);
        if ((++sp & 255u) == 0u) { if (xb_ld(&bar[XB_TMO])) break; if (sp > XB_SPIN_CAP) { atomicAdd(&bar[XB_TMO], 1u); break; } }
    }
    nloc = mine > 0u ? mine : 1u; nx = cnt > 0u ? cnt : 1u;
}
__device__ __forceinline__ void xcd_barrier(const XcdBarrier& b) {
    asm volatile("s_waitcnt vmcnt(0)" ::: "memory");
    __syncthreads();
    if (threadIdx.x == 0) {
        unsigned* bar = b.bar;
        __builtin_amdgcn_s_waitcnt(0);
        unsigned nloc = b.st[0], nx = b.st[1];
        if (nloc == 0u) { xcd_barrier_complete(bar, b.x, nloc, nx); b.st[0] = nloc; b.st[1] = nx; }
        const unsigned old = xb_add(&bar[XB_XSUB(b.x)], 1u);
        const unsigned gen = old / nloc;
        if (old + 1u == (gen + 1u) * nloc) {
            __builtin_amdgcn_fence(__ATOMIC_RELEASE, "agent");
            asm volatile("s_waitcnt vmcnt(0)" ::: "memory");
            const unsigned og = xb_add(&bar[XB_TOP], 1u);
            const unsigned tg = og / nx;
            if (og + 1u == (tg + 1u) * nx) xb_add(&bar[XB_TOPGEN], 1u);
            else XB_SPIN(xb_ld(&bar[XB_TOPGEN]) == tg, bar);
            __builtin_amdgcn_fence(__ATOMIC_ACQUIRE, "agent");
            xb_add(&bar[XB_XGEN(b.x)], 1u);
            asm volatile("s_waitcnt vmcnt(0)" ::: "memory");
        } else {
            XB_SPIN(xb_ld(&bar[XB_XGEN(b.x)]) == gen, bar);
            __builtin_amdgcn_fence(__ATOMIC_ACQUIRE, "agent");
            asm volatile("s_waitcnt vmcnt(0)" ::: "memory");
        }
    }
    __syncthreads();
}

__device__ __forceinline__ float wave_sum(float v) {
#define WS_DPP(x, ctrl) __builtin_bit_cast(float, __builtin_amdgcn_update_dpp(0, __builtin_bit_cast(int, (x)), (ctrl), 0xf, 0xf, false))
    v += WS_DPP(v, 0xB1); v += WS_DPP(v, 0x4E); v += WS_DPP(v, 0x141); v += WS_DPP(v, 0x140);
#undef WS_DPP
    const int iv = __builtin_bit_cast(int, v);
    return (__builtin_bit_cast(float, __builtin_amdgcn_readlane(iv, 0)) + __builtin_bit_cast(float, __builtin_amdgcn_readlane(iv, 16)))
         + (__builtin_bit_cast(float, __builtin_amdgcn_readlane(iv, 32)) + __builtin_bit_cast(float, __builtin_amdgcn_readlane(iv, 48)));
}
__device__ __forceinline__ int wave_sum_i(int v) {
#pragma unroll
    for (int o = 1; o < 64; o <<= 1) v += __shfl_xor(v, o);
    return v;
}
__device__ __forceinline__ int wave_sum_dpp(int v) {
    v += __builtin_amdgcn_update_dpp(0, v, 0xB1, 0xf, 0xf, false);
    v += __builtin_amdgcn_update_dpp(0, v, 0x4E, 0xf, 0xf, false);
    v += __builtin_amdgcn_update_dpp(0, v, 0x141, 0xf, 0xf, false);
    v += __builtin_amdgcn_update_dpp(0, v, 0x140, 0xf, 0xf, false);
    return __builtin_amdgcn_readlane(v, 0) + __builtin_amdgcn_readlane(v, 16) + __builtin_amdgcn_readlane(v, 32) + __builtin_amdgcn_readlane(v, 48);
}
template <bool F8>
__device__ __forceinline__ void rms_rows_h16(const h16* __restrict__ x, const float* __restrict__ g, h16* __restrict__ out, unsigned char* __restrict__ out8, int gw, int NGW, int lane) {
    f32x4 ga[4], gb[4];
#pragma unroll
    for (int j = 0; j < 4; ++j) { ga[j] = *(const f32x4*)(g + 8 * (lane + 64 * j)); gb[j] = *(const f32x4*)(g + 8 * (lane + 64 * j) + 4); }
    for (int m0 = gw; m0 < M; m0 += 2 * NGW) {
        const int m1 = (m0 + NGW < M) ? m0 + NGW : m0;
        u32x4 r0[4], r1[4];
#pragma unroll
        for (int j = 0; j < 4; ++j) { r0[j] = *((const u32x4*)(x + (size_t)m0 * DM) + lane + 64 * j); r1[j] = *((const u32x4*)(x + (size_t)m1 * DM) + lane + 64 * j); }
        f32x4 va[4], vb[4], wa[4], wb[4]; float s0 = 0.f, s1 = 0.f;
#pragma unroll
        for (int j = 0; j < 4; ++j) { pg8::unpack8h(r0[j], va[j], vb[j]); pg8::unpack8h(r1[j], wa[j], wb[j]);
            s0 += (va[j].x * va[j].x + va[j].y * va[j].y) + (va[j].z * va[j].z + va[j].w * va[j].w) + (vb[j].x * vb[j].x + vb[j].y * vb[j].y) + (vb[j].z * vb[j].z + vb[j].w * vb[j].w);
            s1 += (wa[j].x * wa[j].x + wa[j].y * wa[j].y) + (wa[j].z * wa[j].z + wa[j].w * wa[j].w) + (wb[j].x * wb[j].x + wb[j].y * wb[j].y) + (wb[j].z * wb[j].z + wb[j].w * wb[j].w); }
        const float q0 = 1.0f / sqrtf(wave_sum(s0) * (1.0f / DM) + RMS_EPS), q1 = 1.0f / sqrtf(wave_sum(s1) * (1.0f / DM) + RMS_EPS);
#pragma unroll
        for (int j = 0; j < 4; ++j) { const f32x4 ya = va[j] * q0 * ga[j], yb = vb[j] * q0 * gb[j], za = wa[j] * q1 * ga[j], zb = wb[j] * q1 * gb[j];
            *((u32x4*)(out + (size_t)m0 * DM) + lane + 64 * j) = pg8::pack8h(ya, yb); *((u32x4*)(out + (size_t)m1 * DM) + lane + 64 * j) = pg8::pack8h(za, zb);
            if (F8) { *((u32x2*)(out8 + (size_t)m0 * DM) + lane + 64 * j) = (u32x2){pkf8(ya.x, ya.y, ya.z, ya.w), pkf8(yb.x, yb.y, yb.z, yb.w)};
                      *((u32x2*)(out8 + (size_t)m1 * DM) + lane + 64 * j) = (u32x2){pkf8(za.x, za.y, za.z, za.w), pkf8(zb.x, zb.y, zb.z, zb.w)}; } }
    }
}
__device__ __forceinline__ int t5_bucket(int n) {
    if (n < 16) return n < 0 ? 0 : n;
    int b = 16;
    b += (n >= 22) + (n >= 30) + (n >= 40) + (n >= 54) + (n >= 73) + (n >= 99) + (n >= 134) + (n >= 182) + (n >= 246) + (n >= 332) + (n >= 450) + (n >= 609) + (n >= 825) + (n >= 1117) + (n >= 1513);
    return b;
}
constexpr int T5_FAR = 1513;

template <int MAP> __device__ __forceinline__ int dest_row(int n) {
    if (MAP == 1) return n < 8784 ? n : n + 176;
    if (MAP == 2) return 256 * (n >> 7) + (n & 127);
    if (MAP == 3) return 256 * (n >> 7) + 128 + (n & 127);
    return n;
}
template <int MAP, int OUT8 = 0>
__device__ __forceinline__ void transpose_item(const float* __restrict__ W, int K, int N, h16* __restrict__ WT, LAS float* scr, int item, int lane, int dpitch = 0, int dkoff = 0, unsigned char* __restrict__ WT8 = nullptr, float sc8 = 64.f) {
    if (dpitch == 0) dpitch = K;
    const int nblk = (N + 31) / 32, kb = item / nblk, nb = item - kb * nblk, k0 = 64 * kb, n0 = 32 * nb;
    const int nc = n0 + (lane & 31); const bool okc = nc < N;
    float wv_[32];
#pragma unroll
    for (int i = 0; i < 32; ++i) { const int kk = 2 * i + (lane >> 5); wv_[i] = okc ? W[(size_t)(k0 + kk) * N + nc] : 0.f; }
#pragma unroll
    for (int i = 0; i < 32; ++i) { const int kk = 2 * i + (lane >> 5); scr[kk * 33 + (lane & 31)] = wv_[i]; }
    LDS_WAIT(); asm volatile("" ::: "memory");
    if (MAP == 1 || OUT8) {
        const int c4 = lane & 3;
#pragma unroll
        for (int j = 0; j < 2; ++j) { const int n = (lane >> 2) + 16 * j; const LAS float* s = scr + (16 * c4) * 33 + n;
            u32x4 o; o.x = pkf8(s[0 * 33] * sc8, s[1 * 33] * sc8, s[2 * 33] * sc8, s[3 * 33] * sc8); o.y = pkf8(s[4 * 33] * sc8, s[5 * 33] * sc8, s[6 * 33] * sc8, s[7 * 33] * sc8);
            o.z = pkf8(s[8 * 33] * sc8, s[9 * 33] * sc8, s[10 * 33] * sc8, s[11 * 33] * sc8); o.w = pkf8(s[12 * 33] * sc8, s[13 * 33] * sc8, s[14 * 33] * sc8, s[15 * 33] * sc8);
            if (n0 + n < N) *(u32x4*)(WT8 + (size_t)dest_row<MAP>(n0 + n) * dpitch + dkoff + k0 + 16 * c4) = o; }
        if (OUT8 || !(n0 >= 7680 && n0 < 8784)) { LDS_WAIT(); asm volatile("" ::: "memory"); return; }
    }
    const int c = lane & 7;
#pragma unroll
    for (int j = 0; j < 4; ++j) { const int n = (lane >> 3) + 8 * j; const LAS float* s = scr + (8 * c) * 33 + n;
        const float c16 = MAP == 2 ? LOG2E : (MAP == 3 ? 1.0f / LOG2E : 1.0f);
        u32x4 o; o.x = pkh(s[0 * 33] * c16, s[1 * 33] * c16); o.y = pkh(s[2 * 33] * c16, s[3 * 33] * c16); o.z = pkh(s[4 * 33] * c16, s[5 * 33] * c16); o.w = pkh(s[6 * 33] * c16, s[7 * 33] * c16);
        if (n0 + n < N) *(u32x4*)(WT + (size_t)dest_row<MAP>(n0 + n) * dpitch + dkoff + k0 + 8 * c) = o; }
    LDS_WAIT(); asm volatile("" ::: "memory");
}

namespace att {
constexpr int KROW = 272, VROW = 320, KROW8 = 144, VROW8 = 80;
constexpr int KT_BYTES = 64 * KROW, VT_BYTES = 64 * VROW;
constexpr int OFF_K = 0, OFF_V = 2 * KT_BYTES, OFF_TAB = OFF_V + 2 * VT_BYTES;
constexpr int TABB_DMAX = 4095, TABB_N = 4096 + 128, TABA_DMAX = 255, TABA_N = 256 + 128;
constexpr int KT8 = 2 * 64 * KROW8, VT8B = 2 * 128 * VROW8, OFF_V8 = 2 * KT8, OFF_TAB8 = OFF_V8 + 2 * VT8B;
static_assert(OFF_TAB + TABA_N * 4 <= RING_BYTES && OFF_TAB8 + TABB_N * 4 <= RING_BYTES, "attention LDS");

struct UnitA { const h16* Q; const h16* K; const h16* V; const unsigned char* Q8; const unsigned char* K8; const unsigned char* V8; h16* O; float* lse; size_t pitch; size_t opitch; int lse_pitch; int q0; int t_lo, t_hi; };
__device__ __forceinline__ float max3_nc(float a, float b, float c) { float r; asm("v_max3_f32 %0, %1, %2, %3" : "=v"(r) : "v"(a), "v"(b), "v"(c)); return r; }
__device__ __forceinline__ float max2_nc(float a, float b) { float r; asm("v_max_f32 %0, %1, %2" : "=v"(r) : "v"(a), "v"(b)); return r; }
template <int MODE>
__device__ __forceinline__ void attn_tile(LAS unsigned char* kbuf, LAS unsigned char* vbuf, const LAS float* tab, const h16x8 (&qr)[4], f32x16 (&o)[4], float& m_run, float& l_run,
                                          const int kb_lane, const int vb_lane, const int kb0, const int tq, const int qlo, const int hi, const u32x2 mcur, const float bias_far) {
    constexpr int DMAX = MODE == 0 ? TABA_DMAX : TABB_DMAX;
        f32x16 p0, p1;
#pragma unroll
        for (int r = 0; r < 16; ++r) { p0[r] = 0.f; p1[r] = 0.f; }
        if constexpr (true) {
            const LAS unsigned char* kp = kbuf + kb_lane;
#pragma unroll
            for (int s = 0; s < 2; ++s) { const v8i32 qq = cat8(qr[2 * s], qr[2 * s + 1]);
                const v8i32 a0 = cat8(*(const LAS h16x8*)(kp + 64 * s), *(const LAS h16x8*)(kp + 64 * s + 16)), a1 = cat8(*(const LAS h16x8*)(kp + 32 * KROW8 + 64 * s), *(const LAS h16x8*)(kp + 32 * KROW8 + 64 * s + 16));
                p0 = __builtin_amdgcn_mfma_scale_f32_32x32x64_f8f6f4(a0, qq, p0, 0, 0, 0, 0, 0, 0);
                p1 = __builtin_amdgcn_mfma_scale_f32_32x32x64_f8f6f4(a1, qq, p1, 0, 0, 0, 0, 0, 0); }
        } else { const LAS unsigned char* kp = kbuf + kb_lane;
#pragma unroll
          for (int d0 = 0; d0 < 8; ++d0) { const h16x8 a0 = *(const LAS h16x8*)(kp + 32 * d0), a1 = *(const LAS h16x8*)(kp + 32 * KROW + 32 * d0);
              p0 = __builtin_amdgcn_mfma_f32_32x32x16_f16(a0, qr[d0], p0, 0, 0, 0);
              p1 = __builtin_amdgcn_mfma_f32_32x32x16_f16(a1, qr[d0], p1, 0, 0, 0); } }
        const int dq = tq - kb0 - 4 * hi;
        if (MODE == 1 && (qlo - (kb0 + 63) >= T5_FAR)) {
#pragma unroll
            for (int r = 0; r < 16; ++r) { p0[r] = fmaf(p0[r], C2, bias_far); p1[r] = fmaf(p1[r], C2, bias_far); }
        } else {
            const LAS float* tp = tab + (DMAX - dq);
#pragma unroll
            for (int r = 0; r < 16; ++r) { const int c = (r & 3) + 8 * (r >> 2); p0[r] = fmaf(p0[r], C2, tp[c]); p1[r] = fmaf(p1[r], C2, tp[c + 32]); }
        }
        const float NEG = -__builtin_inff();
        if (MODE == 0) {
#pragma unroll
            for (int r = 0; r < 16; ++r) { const int c = (r & 3) + 8 * (r >> 2);
                if ((unsigned)(dq - c) > 128u) p0[r] = NEG;
                if ((unsigned)(dq - c - 32) > 128u) p1[r] = NEG; }
        }
        float pmax;
        {
            float a_[11], b_[4];
#pragma unroll
            for (int g = 0; g < 5; ++g) { a_[2 * g] = max3_nc(p0[3 * g], p0[3 * g + 1], p0[3 * g + 2]); a_[2 * g + 1] = max3_nc(p1[3 * g], p1[3 * g + 1], p1[3 * g + 2]); }
            a_[10] = max2_nc(p0[15], p1[15]);
            b_[0] = max3_nc(a_[0], a_[1], a_[2]); b_[1] = max3_nc(a_[3], a_[4], a_[5]); b_[2] = max3_nc(a_[6], a_[7], a_[8]); b_[3] = max2_nc(a_[9], a_[10]);
            pmax = max2_nc(max2_nc(b_[0], b_[1]), max2_nc(b_[2], b_[3])); }
        { auto rr = __builtin_amdgcn_permlane32_swap(__float_as_uint(pmax), __float_as_uint(pmax), false, false);
          pmax = fmaxf(__uint_as_float(rr[0]), __uint_as_float(rr[1])); }
        float mn = m_run, alpha = 1.f;
        if (!__all(pmax - m_run <= 8.f)) {
            mn = fmaxf(m_run, pmax); alpha = __builtin_amdgcn_exp2f(m_run - mn); m_run = mn;
#pragma unroll
            for (int d = 0; d < 4; ++d)
#pragma unroll
                for (int r = 0; r < 16; ++r) o[d][r] *= alpha;
        }
#pragma unroll
        for (int r = 0; r < 16; r += 2) { const f32x2 mn2 = {mn, mn};
            const f32x2 t0 = (f32x2){p0[r], p0[r + 1]} - mn2, t1 = (f32x2){p1[r], p1[r + 1]} - mn2;
            p0[r] = __builtin_amdgcn_exp2f(t0.x); p0[r + 1] = __builtin_amdgcn_exp2f(t0.y); p1[r] = __builtin_amdgcn_exp2f(t1.x); p1[r + 1] = __builtin_amdgcn_exp2f(t1.y); }
        if (MODE == 1) {
            const unsigned m0 = mcur.x >> (4 * hi), m1 = mcur.y >> (4 * hi);
#pragma unroll
            for (int r = 0; r < 16; ++r) { const int c = (r & 3) + 8 * (r >> 2);
                int s0_, s1_; asm("v_bfe_i32 %0, %1, %2, 1" : "=v"(s0_) : "v"(m0), "n"(c)); asm("v_bfe_i32 %0, %1, %2, 1" : "=v"(s1_) : "v"(m1), "n"(c));
                p0[r] = __uint_as_float(__float_as_uint(p0[r]) & (unsigned)s0_);
                p1[r] = __uint_as_float(__float_as_uint(p1[r]) & (unsigned)s1_); }
        }
        float ps;
        { f32x2 a_[8];
#pragma unroll
          for (int r = 0; r < 8; ++r) a_[r] = (f32x2){p0[2 * r], p0[2 * r + 1]} + (f32x2){p1[2 * r], p1[2 * r + 1]};
#pragma unroll
          for (int w_ = 4; w_ >= 1; w_ >>= 1)
#pragma unroll
              for (int r = 0; r < w_; ++r) a_[r] += a_[r + w_];
          ps = a_[0].x + a_[0].y; }
        { auto rr = __builtin_amdgcn_permlane32_swap(__float_as_uint(ps), __float_as_uint(ps), false, false);
          ps = __uint_as_float(rr[0]) + __uint_as_float(rr[1]); }
        l_run = l_run * alpha + ps;
        if constexpr (MODE == 1) {
            v8i32 pb;
            pb[0] = (int)pkf8(p0[0], p0[1], p0[2], p0[3]); pb[1] = (int)pkf8(p0[4], p0[5], p0[6], p0[7]); pb[2] = (int)pkf8(p0[8], p0[9], p0[10], p0[11]); pb[3] = (int)pkf8(p0[12], p0[13], p0[14], p0[15]);
            pb[4] = (int)pkf8(p1[0], p1[1], p1[2], p1[3]); pb[5] = (int)pkf8(p1[4], p1[5], p1[6], p1[7]); pb[6] = (int)pkf8(p1[8], p1[9], p1[10], p1[11]); pb[7] = (int)pkf8(p1[12], p1[13], p1[14], p1[15]);
            const LAS unsigned char* vp = vbuf + vb_lane;
#pragma unroll
            for (int d = 0; d < 4; ++d)
                o[d] = __builtin_amdgcn_mfma_scale_f32_32x32x64_f8f6f4(cat8(*(const LAS h16x8*)(vp + 32 * VROW8 * d), *(const LAS h16x8*)(vp + 32 * VROW8 * d + 16)), pb, o[d], 0, 0, 0, 0, 0, 0);
            return;
        }
        h16x8 pf[4];
        { u32x4 w;
          w.x = pkh(p0[0], p0[1]); w.y = pkh(p0[2], p0[3]); w.z = pkh(p0[4], p0[5]); w.w = pkh(p0[6], p0[7]); pf[0] = __builtin_bit_cast(h16x8, w);
          w.x = pkh(p0[8], p0[9]); w.y = pkh(p0[10], p0[11]); w.z = pkh(p0[12], p0[13]); w.w = pkh(p0[14], p0[15]); pf[1] = __builtin_bit_cast(h16x8, w);
          w.x = pkh(p1[0], p1[1]); w.y = pkh(p1[2], p1[3]); w.z = pkh(p1[4], p1[5]); w.w = pkh(p1[6], p1[7]); pf[2] = __builtin_bit_cast(h16x8, w);
          w.x = pkh(p1[8], p1[9]); w.y = pkh(p1[10], p1[11]); w.z = pkh(p1[12], p1[13]); w.w = pkh(p1[14], p1[15]); pf[3] = __builtin_bit_cast(h16x8, w); }
        { const LAS unsigned char* vp = vbuf + vb_lane;
#pragma unroll
          for (int d = 0; d < 4; ++d)
#pragma unroll
              for (int s = 0; s < 4; ++s) {
                  const v4i16_t lo = __builtin_amdgcn_ds_read_tr16_b64_v4i16((LAS v4i16_t*)(vp + (16 * s) * VROW + 64 * d));
                  const v4i16_t hh = __builtin_amdgcn_ds_read_tr16_b64_v4i16((LAS v4i16_t*)(vp + (16 * s + 8) * VROW + 64 * d));
                  typedef short s16x8 __attribute__((ext_vector_type(8)));
                  const s16x8 vv = {lo[0], lo[1], lo[2], lo[3], hh[0], hh[1], hh[2], hh[3]};
                  o[d] = __builtin_amdgcn_mfma_f32_32x32x16_f16(__builtin_bit_cast(h16x8, vv), pf[s], o[d], 0, 0, 0); } }
}
template <int MODE>
__device__ __forceinline__ void attn_unit(LAS unsigned char* lds, const UnitA& U, const unsigned long long* __restrict__ mask, float bias_far, const int tid) {
    const int wid = __builtin_amdgcn_readfirstlane(tid >> 6), lane = tid & 63, r32 = lane & 31, hi = lane >> 5;
    const int qlo = U.q0 + 32 * wid, tq = qlo + r32;
    constexpr int DMAX = MODE == 0 ? TABA_DMAX : TABB_DMAX;
    const LAS float* tab = (const LAS float*)(lds + (MODE == 1 ? OFF_TAB8 : OFF_TAB));
    h16x8 qr[4];
    const int pitch8 = MODE == 1 ? WIDTH_B : (int)U.pitch;
    if constexpr (true) { const unsigned char* qp = U.Q8 + (size_t)(32 * wid + r32) * pitch8 + 32 * hi;
#pragma unroll
      for (int s = 0; s < 2; ++s) { qr[2 * s] = *(const h16x8*)(qp + 64 * s); qr[2 * s + 1] = *(const h16x8*)(qp + 64 * s + 16); }
    } else { const h16* qp = U.Q + (size_t)(32 * wid + r32) * U.pitch + 8 * hi;
#pragma unroll
      for (int d0 = 0; d0 < 8; ++d0) qr[d0] = *(const h16x8*)(qp + 16 * d0); }
    const int sr = tid >> 4, sc = tid & 15;
    const int pitch_i = (int)U.pitch;
    const unsigned goff = (unsigned)(sr * pitch_i + sc * 8) * 2u, ghalf = (unsigned)(32 * pitch_i) * 2u;
    const size_t tstride = (size_t)(64 * pitch_i) * 2u;
    const int kws = (tid >> 3) * KROW8 + (tid & 7) * 16, vws = sr * VROW + sc * 16;
    const unsigned goff8 = (unsigned)((tid >> 3) * pitch8 + (tid & 7) * 16);
    const int vws8 = (tid >> 2) * VROW8 + (tid & 3) * 16;
    h16x8 sA0, sA1, sA2, sA3, sB0, sB1, sB2, sB3;
#define ATT_LOADS(K0, K1, V0, V1, t) do { \
        if constexpr (MODE == 1) { const char* kb__ = (const char*)U.K8 + (size_t)(t) * (64 * WIDTH_B); K0 = *(const h16x8*)(kb__ + goff8); V0 = *(const h16x8*)((const char*)U.V8 + (size_t)(t) * 8192 + (unsigned)(tid * 16)); } \
        else { const char* kb__ = (const char*)U.K8 + (size_t)(t) * (size_t)(64 * pitch8); const char* vb__ = (const char*)U.V + (size_t)(t) * tstride; K0 = *(const h16x8*)(kb__ + goff8); \
               V0 = *(const h16x8*)(vb__ + goff); V1 = *(const h16x8*)(vb__ + ghalf + goff); } } while (0)
#define ATT_LOADM(t) (*(const u32x2*)((const char*)(mask + (t)) + moff))
#define ATT_WRITES(K0, K1, V0, V1, buf) do { LAS unsigned char* kb_ = lds + OFF_K + (buf) * KT_BYTES; LAS unsigned char* vb_ = lds + OFF_V + (buf) * VT_BYTES; \
        if constexpr (MODE == 1) { *(LAS h16x8*)(kb_ + kws) = K0; *(LAS h16x8*)(vb_ + vws8) = V0; } \
        else { *(LAS h16x8*)(kb_ + kws) = K0; *(LAS h16x8*)(vb_ + vws) = V0; *(LAS h16x8*)(vb_ + vws + 32 * VROW) = V1; } } while (0)
#define ATT_ACT(t) (MODE == 0 ? ((64 * (t) <= qlo + 31) && (64 * (t) + 63 >= qlo - 128)) : (64 * (t) <= qlo + 31))
    const int T0 = U.t_lo, T1 = U.t_hi;
    float zf_ = 0.f; asm volatile("" : "+v"(zf_));
    u32x2 mwA, mwB;
    const unsigned moff = (unsigned)tq * 512u;
    float m_run = -1e30f, l_run = zf_;
    f32x16 o[4];
#pragma unroll
    for (int d = 0; d < 4; ++d)
#pragma unroll
        for (int r = 0; r < 16; ++r) o[d][r] = zf_;
    const int kb_lane = r32 * KROW8 + hi * 32;
    const int vb_lane = MODE == 1 ? r32 * VROW8 + hi * 32 : (4 * hi + ((lane >> 2) & 3)) * VROW + (16 * ((lane >> 4) & 1) + 4 * (lane & 3)) * 2;
    if constexpr (MODE == 1) {
#define B_LOADS(K0, K1, V0, V1, MW, st) do { const char* kb__ = (const char*)U.K8 + (size_t)(st) * (128 * WIDTH_B); const char* vb__ = (const char*)U.V8 + (size_t)(st) * 16384; \
        K0 = *(const h16x8*)(kb__ + goff8); K1 = *(const h16x8*)(kb__ + 64 * WIDTH_B + goff8); V0 = *(const h16x8*)(vb__ + (unsigned)(tid * 16)); V1 = *(const h16x8*)(vb__ + 8192 + (unsigned)(tid * 16)); \
        MW = *(const u32x4*)((const char*)(mask + 2 * (st)) + moff); } while (0)
#define B_WRITES(K0, K1, V0, V1, buf) do { LAS unsigned char* kb_ = lds + (buf) * KT8; LAS unsigned char* vb_ = lds + OFF_V8 + (buf) * VT8B; \
        *(LAS h16x8*)(kb_ + kws) = K0; *(LAS h16x8*)(kb_ + 64 * KROW8 + kws) = K1; *(LAS h16x8*)(vb_ + vws8) = V0; *(LAS h16x8*)(vb_ + 128 * VROW8 + vws8) = V1; } while (0)
        const int NS = (T1 - T0) >> 1;
        u32x4 mA, mB;
        B_LOADS(sA0, sA1, sA2, sA3, mA, 0); mB = mA;
        if (1 < NS) B_LOADS(sB0, sB1, sB2, sB3, mB, 1);
        for (int st = 0; st < NS; st += 2) {
            {   B_WRITES(sA0, sA1, sA2, sA3, 0);
                __syncthreads();
                const u32x4 mc = mA;
                if (st + 2 < NS) B_LOADS(sA0, sA1, sA2, sA3, mA, st + 2);
                if (ATT_ACT(2 * st)) attn_tile<MODE>(lds, lds + OFF_V8, tab, qr, o, m_run, l_run, kb_lane, vb_lane, 128 * st, tq, qlo, hi, (u32x2){mc.x, mc.y}, bias_far);
                if (ATT_ACT(2 * st + 1)) attn_tile<MODE>(lds + 64 * KROW8, lds + OFF_V8 + 128 * VROW8, tab, qr, o, m_run, l_run, kb_lane, vb_lane, 128 * st + 64, tq, qlo, hi, (u32x2){mc.z, mc.w}, bias_far); }
            if (st + 1 < NS) {
                B_WRITES(sB0, sB1, sB2, sB3, 1);
                __syncthreads();
                const u32x4 mc = mB;
                if (st + 3 < NS) B_LOADS(sB0, sB1, sB2, sB3, mB, st + 3);
                if (ATT_ACT(2 * st + 2)) attn_tile<MODE>(lds + KT8, lds + OFF_V8 + VT8B, tab, qr, o, m_run, l_run, kb_lane, vb_lane, 128 * st + 128, tq, qlo, hi, (u32x2){mc.x, mc.y}, bias_far);
                if (ATT_ACT(2 * st + 3)) attn_tile<MODE>(lds + KT8 + 64 * KROW8, lds + OFF_V8 + VT8B + 128 * VROW8, tab, qr, o, m_run, l_run, kb_lane, vb_lane, 128 * st + 192, tq, qlo, hi, (u32x2){mc.z, mc.w}, bias_far); }
        }
#undef B_LOADS
#undef B_WRITES
    } else {
    ATT_LOADS(sA0, sA1, sA2, sA3, T0);
    if (T0 + 1 < T1) { ATT_LOADS(sB0, sB1, sB2, sB3, T0 + 1); }
    for (int t = T0; t < T1; t += 2) {
        {   ATT_WRITES(sA0, sA1, sA2, sA3, 0);
            __syncthreads();
            const u32x2 mcur = MODE == 1 ? mwA : (u32x2){0u, 0u};
            if (t + 2 < T1) { ATT_LOADS(sA0, sA1, sA2, sA3, t + 2); if (MODE == 1) mwA = ATT_LOADM(t + 2); }
            if (ATT_ACT(t)) attn_tile<MODE>(lds + OFF_K, lds + OFF_V, tab, qr, o, m_run, l_run, kb_lane, vb_lane, 64 * t, tq, qlo, hi, mcur, bias_far); }
        if (t + 1 < T1) {
            ATT_WRITES(sB0, sB1, sB2, sB3, 1);
            __syncthreads();
            const u32x2 mcur = MODE == 1 ? mwB : (u32x2){0u, 0u};
            if (t + 3 < T1) { ATT_LOADS(sB0, sB1, sB2, sB3, t + 3); if (MODE == 1) mwB = ATT_LOADM(t + 3); }
            if (ATT_ACT(t + 1)) attn_tile<MODE>(lds + OFF_K + KT_BYTES, lds + OFF_V + VT_BYTES, tab, qr, o, m_run, l_run, kb_lane, vb_lane, 64 * (t + 1), tq, qlo, hi, mcur, bias_far); }
    }
    }
#undef ATT_LOADS
#undef ATT_LOADM
#undef ATT_WRITES
#undef ATT_ACT
    const float inv = l_run > 0.f ? 1.0f / l_run : 0.f;
    if (MODE == 1) {
        unsigned char* op8 = (unsigned char*)U.O + (size_t)(32 * wid + r32) * U.opitch + 4 * hi; const float i16 = inv * 16.f;
#pragma unroll
        for (int d = 0; d < 4; ++d)
#pragma unroll
            for (int g4 = 0; g4 < 4; ++g4) *(unsigned*)(op8 + 32 * d + 8 * g4) = pkf8(o[d][4 * g4] * i16, o[d][4 * g4 + 1] * i16, o[d][4 * g4 + 2] * i16, o[d][4 * g4 + 3] * i16);
    } else {
    h16* op = U.O + (size_t)(32 * wid + r32) * U.opitch + 4 * hi;
#pragma unroll
    for (int d = 0; d < 4; ++d)
#pragma unroll
        for (int g4 = 0; g4 < 4; ++g4) { u32x2 w; w.x = pkh(o[d][4 * g4] * inv, o[d][4 * g4 + 1] * inv); w.y = pkh(o[d][4 * g4 + 2] * inv, o[d][4 * g4 + 3] * inv);
            *(u32x2*)(op + 32 * d + 8 * g4) = w; } }
    if (MODE == 0 && hi == 0) U.lse[(size_t)(32 * wid + r32) * U.lse_pitch] = m_run + __builtin_amdgcn_logf(l_run);
}
}

struct Args { const float* in[12]; float* out; unsigned char* ws; int ph_lo, ph_hi; };
#define AS4 __attribute__((address_space(4)))
typedef const unsigned char AS4* kaptr;
__device__ __forceinline__ kaptr get_ka() { kaptr p = (kaptr)__builtin_amdgcn_kernarg_segment_ptr(); asm volatile("" : "+s"(p)); return p; }
#define KA_IN(ka, k) (*(const float* const AS4*)((ka) + 8 * (k)))
#define KA_OUT(ka) (*(float* const AS4*)((ka) + 96))
#define KA_WS(ka) (*(unsigned char* const AS4*)((ka) + 104))
#define KA_LO(ka) (*(const int AS4*)((ka) + 112))
#define KA_HI(ka) (*(const int AS4*)((ka) + 116))

__global__ void __launch_bounds__(NTHREADS, 2) fwd_kernel(Args args) {
    extern __shared__ __attribute__((aligned(16))) unsigned char lds_raw[];
    LAS unsigned char* lds = (LAS unsigned char*)lds_raw;
    volatile LAS unsigned* MISC = (volatile LAS unsigned*)(lds + MISC_OFF);
#define WSP(T, off) ((T*)(ws + (off)))
#define W1T WSP(h16, WS_W1)
#define WAB8 WSP(unsigned char, WS_WA)
#define W1F8 WSP(unsigned char, WS_W1)
#define H8 WSP(unsigned char, WS_X)
#define WO8 WSP(unsigned char, WS_WO)
#define WGUT WSP(h16, WS_WGU)
#define WDT WSP(h16, WS_WD)
#define H16 ((h16*)KA_OUT(ka))
#define XS ((h16*)KA_OUT(ka) + (size_t)M * DM)
#define XF WSP(h16, WS_H16)
#define OA WSP(h16, WS_H16)
#define QA WSP(h16, WS_QA)
#define KA WSP(h16, WS_KA)
#define VA WSP(h16, WS_VA)
#define YY8 WSP(unsigned char, WS_QA)
#define MASK WSP(unsigned long long, WS_VA)
#define QB WSP(h16, WS_QB)
#define KB WSP(h16, WS_KB)
#define VB WSP(h16, WS_VB)
#define VT8 WSP(unsigned char, WS_VB)
#define QI WSP(h16, WS_QI)
#define KI WSP(h16, WS_KI)
#define WI WSP(float, WS_WI)
#define LSE WSP(float, WS_LSE)
#define GA WSP(unsigned char, WS_GA)
#define GB (WSP(unsigned char, WS_GA) + (size_t)M * DM)
#define SC WSP(unsigned short, WS_X)
#define MG8 WSP(unsigned char, WS_X)
#define HID WSP(h16, WS_X)
#define FRESH_TID(name) int name; { int zt_ = 0; asm volatile("" : "+v"(zt_)); name = wave_s * 64 + (int)__builtin_amdgcn_mbcnt_hi(~0u, __builtin_amdgcn_mbcnt_lo(~0u, (unsigned)zt_)); asm volatile("" : "+v"(name)); }
#define PH_ENTER() const kaptr ka = get_ka(); unsigned char* const ws = KA_WS(ka); (void)ws; \
    int z_ = 0; asm volatile("" : "+v"(z_)); int tid = wave_s * 64 + (int)__builtin_amdgcn_mbcnt_hi(~0u, __builtin_amdgcn_mbcnt_lo(~0u, (unsigned)z_)); asm volatile("" : "+v"(tid)); int bx = blockIdx.x; asm volatile("" : "+s"(bx)); int G = gridDim.x; asm volatile("" : "+s"(G)); \
    const int lane = tid & 63, wave = __builtin_amdgcn_readfirstlane(tid >> 6), gw = bx * NWAVES + wave, NGW = G * NWAVES; (void)lane; (void)gw; (void)NGW
    for (int u = threadIdx.x; u < (LDS_BYTES - LDSCTL_OFF) / 4; u += NTHREADS) ((LAS unsigned*)(lds + LDSCTL_OFF))[u] = 0u;
    const int wave_s = __builtin_amdgcn_readfirstlane(threadIdx.x >> 6);
    __syncthreads();
    XcdBarrier bar; int lo, hi_ph;
    { const kaptr ka = get_ka(); unsigned* ctl = (unsigned*)(KA_WS(ka) + WS_CTL); lo = KA_LO(ka); hi_ph = KA_HI(ka);
      bar.bar = ctl + CW_BAR; bar.x = 0; bar.st = nullptr;
      if (!MK_PER_PHASE_LAUNCH) bar = xcd_barrier_post(ctl + CW_BAR, MISC + 8); }
#define IN(k) (lo <= (k) && (k) < hi_ph)
#define SEAM(k) do { if (!MK_PER_PHASE_LAUNCH && IN(k) && IN((k) + 1)) xcd_barrier(bar); } while (0)

    { constexpr int layer = 0;
        const int P = layer * 10;
        if (IN(P + 0)) PH_REP(0) {
            PH_ENTER();
            const float* w_in = KA_IN(ka, 1) + (size_t)layer * DM * DIN;
            const float* w_oa = KA_IN(ka, 2) + (size_t)layer * 512 * DM;
            const float* w_ob = KA_IN(ka, 3) + (size_t)layer * 1024 * DM;
            const float* w_o = KA_IN(ka, 4) + (size_t)layer * DM * DM;
            const float* w_fg = KA_IN(ka, 5) + (size_t)layer * DM * DFF;
            const float* w_fu = KA_IN(ka, 6) + (size_t)layer * DM * DFF;
            const float* w_fd = KA_IN(ka, 7) + (size_t)layer * DFF * DM;
            const float* g_mix = KA_IN(ka, 8) + (size_t)layer * DM;
            const float* xcur = KA_IN(ka, 0);
            LAS float* scr = (LAS float*)(lds + wave * 16384);
            constexpr int I1_ = (DM / 64) * ((DIN + 31) / 32), IG = (DM / 64) * (DFF / 32), ID = (DFF / 64) * (DM / 32), IA = (512 / 64) * (DM / 32), IB = (1024 / 64) * (DM / 32), IO = (DM / 64) * (DM / 32);
            constexpr int NITEMS = I1_ + 2 * IG + ID + IA + IB + IO;
            for (int it = gw; it < NITEMS; it += NGW) {
                int r = it;
                if (r < I1_) { transpose_item<1>(w_in, DM, DIN, W1T, scr, r, lane, 0, 0, W1F8); continue; } r -= I1_;
                if (r < IG) { transpose_item<2>(w_fg, DM, DFF, WGUT, scr, r, lane); continue; } r -= IG;
                if (r < IG) { transpose_item<3>(w_fu, DM, DFF, WGUT, scr, r, lane); continue; } r -= IG;
                if (r < ID) { if (F8_DOWN(layer)) transpose_item<0, 1>(w_fd, DFF, DM, nullptr, scr, r, lane, 0, 0, (unsigned char*)WDT, 128.f); else transpose_item<0>(w_fd, DFF, DM, WDT, scr, r, lane); continue; } r -= ID;
                if (r < IA) { transpose_item<0, 1>(w_oa, 512, DM, nullptr, scr, r, lane, 1536, 0, WAB8, 32.f); continue; } r -= IA;
                if (r < IB) { transpose_item<0, 1>(w_ob, 1024, DM, nullptr, scr, r, lane, 1536, 512, WAB8, 32.f); continue; } r -= IB;
                transpose_item<0, 1>(w_o, DM, DM, nullptr, scr, r, lane, 0, 0, WO8, 64.f);
            }
            { u32x4* z = (u32x4*)(W1T + (size_t)8784 * DM); const int nz = 176 * DM * 2 / 16;
              for (int i = bx * NTHREADS + tid; i < nz; i += G * NTHREADS) z[i] = (u32x4){0u, 0u, 0u, 0u}; }
            if (layer == 0) {
                f32x4 gv[8];
#pragma unroll
                for (int j = 0; j < 8; ++j) gv[j] = *((const f32x4*)g_mix + lane + 64 * j);
                for (int m = gw; m < M; m += NGW) {
                    const f32x4* xr = (const f32x4*)(xcur + (size_t)m * DM) + lane; f32x4 v[8]; float s = 0.f;
#pragma unroll
                    for (int j = 0; j < 8; ++j) { v[j] = xr[64 * j]; s += (v[j].x * v[j].x + v[j].y * v[j].y) + (v[j].z * v[j].z + v[j].w * v[j].w); }
                    const float rs = 1.0f / sqrtf(wave_sum(s) * (1.0f / DM) + RMS_EPS);
                    u32x2* o8 = (u32x2*)(H16 + (size_t)m * DM) + lane; u32x2* x8 = (u32x2*)(XS + (size_t)m * DM) + lane;
#pragma unroll
                    for (int j = 0; j < 8; ++j) { const f32x4 y = v[j] * rs * gv[j]; u32x2 w; w.x = pkh(y.x, y.y); w.y = pkh(y.z, y.w); o8[64 * j] = w;
                        ((unsigned*)(H8 + (size_t)m * DM))[lane + 64 * j] = pkf8(y.x, y.y, y.z, y.w);
                        u32x2 xw; xw.x = pkh(v[j].x, v[j].y); xw.y = pkh(v[j].z, v[j].w); x8[64 * j] = xw; }
                }
            } else {
                rms_rows_h16<true>(XS, g_mix, H16, H8, gw, NGW, lane);
            }
        }
        SEAM(P + 0);

        if (IN(P + 1)) PH_REP(1) {
            PH_ENTER();
            const bool idx_last = (bx >> 3) & 1;
            if (!idx_last) {
                pg8::Gemm g{H16, W1T, M, NP1, DM}; pg8::IdxOrder S; S.init(G, bx);
                pg8::EpiProj E{QA, QB, QI, KI, GA, WI, 1.0f};
                pg8::gemm_phase<pg8::EpiProj, pg8::IdxOrder, 0, false>(lds, g, S, E, tid); }
            { pg8::Gemm g{(const h16*)H8, (const h16*)W1F8, M, NP1, DM}; pg8::F8Order S; S.init(G, bx);
              pg8::EpiProj E{QA, QB, QI, KI, GA, WI, 1.0f / 64.0f};
              FRESH_TID(tid2); pg8::gemm_phase<pg8::EpiProj, pg8::F8Order, 0, true>(lds, g, S, E, tid2); }
            { pg8::Gemm g{(const h16*)W1F8, (const h16*)H8, NP1, M, DM}; pg8::VtOrder S; S.init(G, bx);
              pg8::EpiVT E{VT8, 1.0f / 64.0f};
              FRESH_TID(tid3); pg8::gemm_phase<pg8::EpiVT, pg8::VtOrder, 0, true>(lds, g, S, E, tid3); }
            if (idx_last) {
                int bx2 = blockIdx.x; asm volatile("" : "+s"(bx2)); int G2 = gridDim.x; asm volatile("" : "+s"(G2));
                pg8::Gemm g{H16, W1T, M, NP1, DM}; pg8::IdxOrder S; S.init(G2, bx2);
                pg8::EpiProj E{QA, QB, QI, KI, GA, WI, 1.0f};
                FRESH_TID(tid4); pg8::gemm_phase<pg8::EpiProj, pg8::IdxOrder, 0, false>(lds, g, S, E, tid4); }
        }
        SEAM(P + 1);

        if (IN(P + 2)) PH_REP(2) {
            PH_ENTER();
            const float* rel_bias = KA_IN(ka, 11);
            PH_REP(10) for (int u0 = bx; u0 < 768; u0 += G) {
                const int u = (u0 & 7) * 96 + (u0 >> 3);
                const int b = u / 192, rem = u - b * 192, g = rem >> 6, rem2 = rem & 63, hh = rem2 >> 4, xx = rem2 & 15;
                const int dil = g == 0 ? 1 : (g == 1 ? 4 : 16), nblk = 16 / dil, res = xx / nblk, blk = xx - res * nblk;
                __syncthreads();
                { LAS float* tabw = (LAS float*)(lds + att::OFF_TAB);
                  for (int i = tid; i < att::TABA_N; i += NTHREADS) { const int dist = att::TABA_DMAX - i;
                      tabw[i] = (dist >= 0 && dist <= 128) ? rel_bias[t5_bucket(dist * dil) * 20 + g * 4 + hh] * LOG2E : 0.f; } }
                att::UnitA U; const size_t base = ((size_t)b * SEQ + res) * WIDTH_A + g * 512 + hh * 128;
                U.pitch = (size_t)dil * WIDTH_A; U.opitch = U.pitch; U.q0 = 256 * blk;
                U.K = nullptr; U.Q = nullptr; U.K8 = (const unsigned char*)KA + base; U.Q8 = (const unsigned char*)QA + base + (size_t)U.q0 * U.pitch; U.V = VA + base; U.O = OA + base + (size_t)U.q0 * U.pitch;
                U.lse = LSE + ((size_t)b * SEQ + res + (size_t)U.q0 * dil) * 12 + g * 4 + hh; U.lse_pitch = dil * 12;
                U.t_lo = blk == 0 ? 0 : 4 * blk - 2; U.t_hi = 4 * blk + 4;
                att::attn_unit<0>(lds, U, nullptr, 0.f, tid);
            }
            __syncthreads();
            {
                LAS float* wT = (LAS float*)lds;
                float wnx[4]; h16x8 knx[4]; bool have_nx = false;
                auto i1_item = [&](auto tln_c, const int u, const int qs, const int kh, const int tl0, const int unext) {
                    constexpr int TLN = decltype(tln_c)::value;
                    int tid_u = tid; asm volatile("" : "+v"(tid_u));
                    const int lane_u = tid_u & 63, r32 = lane_u & 31, hi = lane_u >> 5;
                    const int b = u / 272; int rem = u - b * 272, i = 0;
                    { int p = 0; for (;;) { const int c = (i >> 1) + 1; if (rem < p + c) break; p += c; ++i; } rem -= p; }
                    const int j = rem;
                    float wpre[4]; h16x8 kpre[4];
                    if (have_nx) {
#pragma unroll
                        for (int e4 = 0; e4 < 4; ++e4) { wpre[e4] = wnx[e4]; kpre[e4] = knx[e4]; }
                    } else { const float* wg = WI + ((size_t)b * SEQ + 128 * i) * 16; const h16* kg = KI + ((size_t)b * SEQ + 256 * j) * 64;
#pragma unroll
                      for (int e4 = 0; e4 < 4; ++e4) { const int e = tid_u + NTHREADS * e4; wpre[e4] = wg[e]; kpre[e4] = *(const h16x8*)(kg + (size_t)(e >> 3) * 64 + (e & 7) * 8); } }
#define I1_PREFETCH() do { have_nx = unext >= 0; if (have_nx) { const int bn = unext / 272; int remn = unext - bn * 272, in_ = 0; { int p = 0; for (;;) { const int c = (in_ >> 1) + 1; if (remn < p + c) break; p += c; ++in_; } remn -= p; } \
                        const float* wg = WI + ((size_t)bn * SEQ + 128 * in_) * 16; const h16* kg = KI + ((size_t)bn * SEQ + 256 * remn) * 64; int tp_ = tid; asm volatile("" : "+v"(tp_)); \
                        _Pragma("unroll") for (int e4 = 0; e4 < 4; ++e4) { const int e = tp_ + NTHREADS * e4; wnx[e4] = wg[e]; knx[e4] = *(const h16x8*)(kg + (size_t)(e >> 3) * 64 + (e & 7) * 8); } } \
                        else { _Pragma("unroll") for (int e4 = 0; e4 < 4; ++e4) { wnx[e4] = 0.f; knx[e4] = (h16x8){0, 0, 0, 0, 0, 0, 0, 0}; } } } while (0)
                    __syncthreads();
#pragma unroll
                    for (int e4 = 0; e4 < 4; ++e4) { const int e = tid_u + NTHREADS * e4; wT[(e & 15) * 128 + (e >> 4)] = wpre[e4] * 0.03125f;
                        *(LAS h16x8*)(lds + 8192 + (e >> 3) * 144 + (e & 7) * 16) = kpre[e4]; }
                    __syncthreads();
                    if (2 * j + kh <= i) {
                    const size_t tok0 = (size_t)b * SEQ + 128 * i + 32 * qs;
                    const LAS unsigned char* kl = lds + 8192 + (128 * kh + 32 * tl0 + r32) * 144 + hi * 16;
                    f32x16 acc[TLN];
                    const char* qbase = (const char*)(QI + tok0 * 1024); const unsigned qoff = (unsigned)(r32 * 1024 + 8 * hi) * 2u;
                    h16x8 afA[4], afB[4];
                    h16x8 kf[TLN][4];
#pragma unroll
                    for (int tl = 0; tl < TLN; ++tl)
#pragma unroll
                        for (int ks = 0; ks < 4; ++ks) kf[tl][ks] = *(const LAS h16x8*)(kl + (32 * tl) * 144 + 32 * ks);
#define I1_LOAD(dst, h_) do { unsigned vo_ = qoff; const char* qb_ = qbase + (size_t)(128 * (h_)); asm volatile("" : "+v"(vo_), "+s"(qb_)); \
                        _Pragma("unroll") for (int ks = 0; ks < 4; ++ks) dst[ks] = *(const h16x8*)(qb_ + vo_ + 32 * ks); } while (0)
#define I1_HEAD(af, h_, FIRST) do { const float wq_ = wT[(h_) * 128 + 32 * qs + r32]; \
                        _Pragma("unroll") for (int tl = 0; tl < TLN; ++tl) { f32x16 d; \
                            _Pragma("unroll") for (int r = 0; r < 16; ++r) d[r] = 0.f; \
                            _Pragma("unroll") for (int ks = 0; ks < 4; ++ks) d = __builtin_amdgcn_mfma_f32_32x32x16_f16(kf[tl][ks], af[ks], d, 0, 0, 0); \
                            _Pragma("unroll") for (int r = 0; r < 16; ++r) acc[tl][r] = (FIRST) ? I1_RELU(d[r]) * wq_ : fmaf(I1_RELU(d[r]), wq_, acc[tl][r]); } } while (0)
                    I1_LOAD(afA, 0);
                    I1_LOAD(afB, 1);
                    I1_HEAD(afA, 0, true);
                    I1_LOAD(afA, 2);
                    I1_HEAD(afB, 1, false);
#pragma unroll 1
                    for (int h = 2; h < 16; h += 2) {
                        I1_LOAD(afB, h + 1);
                        I1_HEAD(afA, h, false);
                        if (h + 2 < 16) I1_LOAD(afA, h + 2);
                        I1_HEAD(afB, h + 1, false);
                    }
#undef I1_LOAD
#undef I1_HEAD
                    I1_PREFETCH();
                    const int Li = 128 * (i + 1);
                    int zs_ = 0; asm volatile("" : "+v"(zs_)); const int lane_s = (int)__builtin_amdgcn_mbcnt_hi(~0u, __builtin_amdgcn_mbcnt_lo(~0u, (unsigned)zs_)), r32s = lane_s & 31, his = lane_s >> 5;
                    unsigned short* sp = SC + ((size_t)b * 528 + (size_t)(i * (i + 1) / 2)) * 16384 + (size_t)(32 * qs + r32s) * Li + 256 * j + 128 * kh + 32 * tl0 + 8 * his;
#pragma unroll
                    for (int tl = 0; tl < TLN; ++tl)
#pragma unroll
                        for (int pg = 0; pg < 2; ++pg) { const int g = 2 * pg;
                            const unsigned a0 = pkh(acc[tl][4 * g], acc[tl][4 * g + 1]), a1 = pkh(acc[tl][4 * g + 2], acc[tl][4 * g + 3]), b0 = pkh(acc[tl][4 * g + 4], acc[tl][4 * g + 5]), b1 = pkh(acc[tl][4 * g + 6], acc[tl][4 * g + 7]);
                            const auto s0 = __builtin_amdgcn_permlane32_swap(a0, b0, false, false), s1 = __builtin_amdgcn_permlane32_swap(a1, b1, false, false);
                            *(u32x4*)(sp + 32 * tl + 16 * pg) = (u32x4){s0[0], s1[0], s0[1], s1[1]}; }
                    } else { I1_PREFETCH(); }
#undef I1_PREFETCH
                };
                PH_REP(11) { const int nfull = G == 256 ? 1024 : 1088;
                    const int uq = G == 256 ? (bx & 7) * 136 + 128 + (bx >> 5) : -1;
                    for (int u0 = bx; u0 < nfull; u0 += G) { const int un = u0 + G; i1_item(IC<4>{}, (u0 & 7) * 136 + (u0 >> 3), wave & 3, wave >> 2, 0, un < nfull ? (un & 7) * 136 + (un >> 3) : uq); }
                    if (G == 256) i1_item(IC<1>{}, uq, (bx >> 3) & 3, wave >> 2, wave & 3, -1); }
            }
        }
        SEAM(P + 2);

        if (IN(P + 3)) PH_REP(3) {
            PH_ENTER();
            PH_REP(12) for (int it = gw; it < M; it += NGW) {
                const int b = it >> 12, t0_ = it & 4095, t = t0_ < 2048 ? t0_ : 6143 - t0_, rw = (b << 12) + t, i = t >> 7, rr = t & 127, n = t + 1, nj = (n + 63) >> 6;
                const unsigned short* row = SC + ((size_t)b * 528 + (size_t)(i * (i + 1) / 2)) * 16384 + (size_t)rr * (128 * (i + 1));
                unsigned mlo = 0u, mhi = 0u;
#define TK_PUT(j, bl) do { const bool me_ = lane == (j); mlo = me_ ? (unsigned)(bl) : mlo; mhi = me_ ? (unsigned)((bl) >> 32) : mhi; asm volatile("" : "+v"(mlo), "+v"(mhi)); } while (0)
                if (n <= TOPK) {
#pragma unroll
                    for (int j = 0; j < 4; ++j) { const unsigned long long bl = __ballot(64 * j + lane < n); TK_PUT(j, bl); }
                } else {
                    unsigned uk[64];
#pragma unroll
                    for (int j = 0; j < 64; ++j) uk[j] = 0u;
#pragma unroll
                    for (int g8 = 0; g8 < 8; ++g8) if (8 * g8 < nj) {
#pragma unroll
                        for (int jj = 0; jj < 8; ++jj) { const int k = 64 * (8 * g8 + jj) + lane; uk[8 * g8 + jj] = (unsigned)row[k < n ? k : n - 1]; } }
#pragma unroll
                    for (int g8 = 0; g8 < 8; ++g8) if (8 * g8 < nj) {
#pragma unroll
                        for (int jj = 0; jj < 8; ++jj) { const int j = 8 * g8 + jj, k = 64 * j + lane;
                            unsigned bits = uk[j]; if (bits == 0x8000u) bits = 0u;
                            const unsigned key = (bits & 0x8000u) ? (~bits & 0xffffu) : (bits | 0x8000u); uk[j] = k < n ? key : 0u; } }
                    unsigned T = 0u; bool exact = false;
                    for (int bit = 15; bit >= 0; --bit) {
                        const unsigned cand = T | (1u << bit); int cl = 0;
#pragma unroll
                        for (int g8 = 0; g8 < 8; ++g8) if (8 * g8 < nj) {
#pragma unroll
                            for (int jj = 0; jj < 8; ++jj) cl += (uk[8 * g8 + jj] >= cand) ? 1 : 0; }
                        const int c = wave_sum_dpp(cl);
                        if (c >= TOPK) { T = cand; if (c == TOPK) { exact = true; break; } }
                    }
                    if (exact) {
#pragma unroll
                        for (int g8 = 0; g8 < 8; ++g8) if (8 * g8 < nj) {
#pragma unroll
                            for (int jj = 0; jj < 8; ++jj) { const unsigned long long bs = __ballot(uk[8 * g8 + jj] >= T); TK_PUT(8 * g8 + jj, bs); } }
                    } else {
                        int cgl = 0;
#pragma unroll
                        for (int g8 = 0; g8 < 8; ++g8) if (8 * g8 < nj) {
#pragma unroll
                            for (int jj = 0; jj < 8; ++jj) cgl += (uk[8 * g8 + jj] > T) ? 1 : 0; }
                        const int need = TOPK - wave_sum_dpp(cgl); int tb = 0;
#pragma unroll
                        for (int g8 = 0; g8 < 8; ++g8) if (8 * g8 < nj) {
#pragma unroll
                            for (int jj = 0; jj < 8; ++jj) { const int j = 8 * g8 + jj;
                                const bool eq = uk[j] == T; const unsigned long long be = __ballot(eq);
                                const int rank = tb + __builtin_amdgcn_mbcnt_hi((unsigned)(be >> 32), __builtin_amdgcn_mbcnt_lo((unsigned)be, 0u));
                                const bool sel = (uk[j] > T) || (eq && rank < need);
                                const unsigned long long bs = __ballot(sel); TK_PUT(j, bs);
                                tb += __popcll(be); } }
                    }
                }
#undef TK_PUT
                *(u32x2*)(MASK + (size_t)rw * 64 + lane) = (u32x2){mlo, mhi};
            }
            PH_REP(13) for (int rw0 = gw; rw0 < M; rw0 += 2 * NGW) {
                const int hh = lane >> 4, dd = (lane & 15) * 8;
                int rws[2]; rws[0] = rw0; rws[1] = (rw0 + NGW < M) ? rw0 + NGW : rw0;
                float lq[2][3]; u32x4 oq[2][3];
#pragma unroll
                for (int q = 0; q < 2; ++q) { const float* lp = LSE + (size_t)rws[q] * 12 + hh; lq[q][0] = lp[0]; lq[q][1] = lp[4]; lq[q][2] = lp[8];
                    const h16* op = OA + (size_t)rws[q] * WIDTH_A + hh * 128 + dd; oq[q][0] = *(const u32x4*)(op); oq[q][1] = *(const u32x4*)(op + 512); oq[q][2] = *(const u32x4*)(op + 1024); }
#pragma unroll
                for (int q = 0; q < 2; ++q) {
                    const float mx = fmaxf(lq[q][0], fmaxf(lq[q][1], lq[q][2]));
                    float w0 = __builtin_amdgcn_exp2f(lq[q][0] - mx), w1 = __builtin_amdgcn_exp2f(lq[q][1] - mx), w2 = __builtin_amdgcn_exp2f(lq[q][2] - mx);
                    const float inv = 1.0f / (w0 + w1 + w2); w0 *= inv; w1 *= inv; w2 *= inv;
                    f32x4 a0, a1, b0, b1, c0, c1;
                    pg8::unpack8h(oq[q][0], a0, a1); pg8::unpack8h(oq[q][1], b0, b1); pg8::unpack8h(oq[q][2], c0, c1);
                    const f32x4 y0 = a0 * w0 + b0 * w1 + c0 * w2, y1 = a1 * w0 + b1 * w1 + c1 * w2;
                    *(u32x2*)(YY8 + (size_t)rws[q] * 1536 + hh * 128 + dd) = (u32x2){pkf8(y0.x * 16.f, y0.y * 16.f, y0.z * 16.f, y0.w * 16.f), pkf8(y1.x * 16.f, y1.y * 16.f, y1.z * 16.f, y1.w * 16.f)};
                }
            }
        }
        SEAM(P + 3);

        if (IN(P + 4)) PH_REP(4) {
            PH_ENTER();
            const float* rel_bias = KA_IN(ka, 11);
            for (int pu = bx; pu < 256; pu += G) {
                const int xcd_ = pu & 7, slot_ = pu >> 3, bh = 8 * (slot_ >> 3) + xcd_, pr = slot_ & 7, b = bh >> 3, h = bh & 7;
                for (int pass = 0; pass < 2; ++pass) {
                    const int qb = pass == 0 ? 15 - pr : pr;
                    __syncthreads();
                    { LAS float* tabw = (LAS float*)(lds + att::OFF_TAB8);
                      for (int i = tid; i < att::TABB_N; i += NTHREADS) { const int dist = att::TABB_DMAX - i;
                          tabw[i] = dist >= 0 ? rel_bias[t5_bucket(dist) * 20 + 12 + h] * LOG2E : 0.f; } }
                    att::UnitA U; const size_t base = (size_t)b * SEQ * WIDTH_B + h * 128;
                    U.pitch = WIDTH_B; U.opitch = 1536; U.q0 = 256 * qb;
                    U.K = nullptr; U.Q = nullptr; U.K8 = (const unsigned char*)KB + base; U.Q8 = (const unsigned char*)QB + base + (size_t)U.q0 * WIDTH_B; U.V = nullptr; U.V8 = VT8 + (size_t)(b * 8 + h) * (64 * 8192); U.O = (h16*)(YY8 + ((size_t)b * SEQ + U.q0) * 1536 + 512 + h * 128);
                    U.lse = nullptr; U.lse_pitch = 0; U.t_lo = 0; U.t_hi = 4 * qb + 4;
                    att::attn_unit<1>(lds, U, MASK + (size_t)b * SEQ * 64, rel_bias[31 * 20 + 12 + h] * LOG2E, tid);
                }
            }
            __syncthreads();
        }
        SEAM(P + 4);

        if (IN(P + 5)) PH_REP(5) {
            PH_ENTER();
            pg8::Gemm g{(const h16*)YY8, (const h16*)WAB8, M, DM, 1536}; pg8::StaticOrder S; S.init(M, DM, G, bx); pg8::EpiMerge E{GA, GB, MG8};
            pg8::gemm_phase<pg8::EpiMerge, pg8::StaticOrder, 4, true>(lds, g, S, E, tid);
        }
        SEAM(P + 5);

        if (IN(P + 6)) PH_REP(6) {
            PH_ENTER();
            pg8::Gemm g{(const h16*)MG8, (const h16*)WO8, M, DM, DM}; pg8::StaticOrder S; S.init(M, DM, G, bx); pg8::EpiResid E{XS, XS, 1.0f / 1024.0f};
            pg8::gemm_phase<pg8::EpiResid, pg8::StaticOrder, 0, true>(lds, g, S, E, tid);
        }
        SEAM(P + 6);

        if (IN(P + 7)) PH_REP(7) {
            PH_ENTER();
            const float* g_ffn = KA_IN(ka, 9) + (size_t)layer * DM;
            rms_rows_h16<false>(XS, g_ffn, H16, nullptr, gw, NGW, lane);
        }
        SEAM(P + 7);

        if (IN(P + 8)) PH_REP(8) {
            PH_ENTER();
            pg8::Gemm g{H16, WGUT, M, NGU, DM}; pg8::StaticOrder S; S.init(M, NGU, G, bx); pg8::EpiSwiglu<F8_DOWN(layer)> E{HID};
            pg8::gemm_phase<pg8::EpiSwiglu<F8_DOWN(layer)>, pg8::StaticOrder>(lds, g, S, E, tid);
        }
        SEAM(P + 8);

        if (IN(P + 9)) PH_REP(9) {
            PH_ENTER();
            pg8::Gemm g{HID, WDT, M, DM, DFF}; pg8::StaticOrder S; S.init(M, DM, G, bx); pg8::EpiResid E{XS, layer + 1 < DEPTH ? XS : XF, F8_DOWN(layer) ? 1.0f / 512.0f : 1.0f};
            pg8::gemm_phase<pg8::EpiResid, pg8::StaticOrder, 0, F8_DOWN(layer)>(lds, g, S, E, tid);
        }
        SEAM(P + 9);
        }
    { constexpr int layer = 1;
        const int P = layer * 10;
        if (IN(P + 0)) PH_REP(0) {
            PH_ENTER();
            const float* w_in = KA_IN(ka, 1) + (size_t)layer * DM * DIN;
            const float* w_oa = KA_IN(ka, 2) + (size_t)layer * 512 * DM;
            const float* w_ob = KA_IN(ka, 3) + (size_t)layer * 1024 * DM;
            const float* w_o = KA_IN(ka, 4) + (size_t)layer * DM * DM;
            const float* w_fg = KA_IN(ka, 5) + (size_t)layer * DM * DFF;
            const float* w_fu = KA_IN(ka, 6) + (size_t)layer * DM * DFF;
            const float* w_fd = KA_IN(ka, 7) + (size_t)layer * DFF * DM;
            const float* g_mix = KA_IN(ka, 8) + (size_t)layer * DM;
            const float* xcur = KA_IN(ka, 0);
            LAS float* scr = (LAS float*)(lds + wave * 16384);
            constexpr int I1_ = (DM / 64) * ((DIN + 31) / 32), IG = (DM / 64) * (DFF / 32), ID = (DFF / 64) * (DM / 32), IA = (512 / 64) * (DM / 32), IB = (1024 / 64) * (DM / 32), IO = (DM / 64) * (DM / 32);
            constexpr int NITEMS = I1_ + 2 * IG + ID + IA + IB + IO;
            for (int it = gw; it < NITEMS; it += NGW) {
                int r = it;
                if (r < I1_) { transpose_item<1>(w_in, DM, DIN, W1T, scr, r, lane, 0, 0, W1F8); continue; } r -= I1_;
                if (r < IG) { transpose_item<2>(w_fg, DM, DFF, WGUT, scr, r, lane); continue; } r -= IG;
                if (r < IG) { transpose_item<3>(w_fu, DM, DFF, WGUT, scr, r, lane); continue; } r -= IG;
                if (r < ID) { if (F8_DOWN(layer)) transpose_item<0, 1>(w_fd, DFF, DM, nullptr, scr, r, lane, 0, 0, (unsigned char*)WDT, 128.f); else transpose_item<0>(w_fd, DFF, DM, WDT, scr, r, lane); continue; } r -= ID;
                if (r < IA) { transpose_item<0, 1>(w_oa, 512, DM, nullptr, scr, r, lane, 1536, 0, WAB8, 32.f); continue; } r -= IA;
                if (r < IB) { transpose_item<0, 1>(w_ob, 1024, DM, nullptr, scr, r, lane, 1536, 512, WAB8, 32.f); continue; } r -= IB;
                transpose_item<0, 1>(w_o, DM, DM, nullptr, scr, r, lane, 0, 0, WO8, 64.f);
            }
            { u32x4* z = (u32x4*)(W1T + (size_t)8784 * DM); const int nz = 176 * DM * 2 / 16;
              for (int i = bx * NTHREADS + tid; i < nz; i += G * NTHREADS) z[i] = (u32x4){0u, 0u, 0u, 0u}; }
            if (layer == 0) {
                f32x4 gv[8];
#pragma unroll
                for (int j = 0; j < 8; ++j) gv[j] = *((const f32x4*)g_mix + lane + 64 * j);
                for (int m = gw; m < M; m += NGW) {
                    const f32x4* xr = (const f32x4*)(xcur + (size_t)m * DM) + lane; f32x4 v[8]; float s = 0.f;
#pragma unroll
                    for (int j = 0; j < 8; ++j) { v[j] = xr[64 * j]; s += (v[j].x * v[j].x + v[j].y * v[j].y) + (v[j].z * v[j].z + v[j].w * v[j].w); }
                    const float rs = 1.0f / sqrtf(wave_sum(s) * (1.0f / DM) + RMS_EPS);
                    u32x2* o8 = (u32x2*)(H16 + (size_t)m * DM) + lane; u32x2* x8 = (u32x2*)(XS + (size_t)m * DM) + lane;
#pragma unroll
                    for (int j = 0; j < 8; ++j) { const f32x4 y = v[j] * rs * gv[j]; u32x2 w; w.x = pkh(y.x, y.y); w.y = pkh(y.z, y.w); o8[64 * j] = w;
                        ((unsigned*)(H8 + (size_t)m * DM))[lane + 64 * j] = pkf8(y.x, y.y, y.z, y.w);
                        u32x2 xw; xw.x = pkh(v[j].x, v[j].y); xw.y = pkh(v[j].z, v[j].w); x8[64 * j] = xw; }
                }
            } else {
                rms_rows_h16<true>(XS, g_mix, H16, H8, gw, NGW, lane);
            }
        }
        SEAM(P + 0);

        if (IN(P + 1)) PH_REP(1) {
            PH_ENTER();
            const bool idx_last = (bx >> 3) & 1;
            if (!idx_last) {
                pg8::Gemm g{H16, W1T, M, NP1, DM}; pg8::IdxOrder S; S.init(G, bx);
                pg8::EpiProj E{QA, QB, QI, KI, GA, WI, 1.0f};
                pg8::gemm_phase<pg8::EpiProj, pg8::IdxOrder, 0, false>(lds, g, S, E, tid); }
            { pg8::Gemm g{(const h16*)H8, (const h16*)W1F8, M, NP1, DM}; pg8::F8Order S; S.init(G, bx);
              pg8::EpiProj E{QA, QB, QI, KI, GA, WI, 1.0f / 64.0f};
              FRESH_TID(tid2); pg8::gemm_phase<pg8::EpiProj, pg8::F8Order, 0, true>(lds, g, S, E, tid2); }
            { pg8::Gemm g{(const h16*)W1F8, (const h16*)H8, NP1, M, DM}; pg8::VtOrder S; S.init(G, bx);
              pg8::EpiVT E{VT8, 1.0f / 64.0f};
              FRESH_TID(tid3); pg8::gemm_phase<pg8::EpiVT, pg8::VtOrder, 0, true>(lds, g, S, E, tid3); }
            if (idx_last) {
                int bx2 = blockIdx.x; asm volatile("" : "+s"(bx2)); int G2 = gridDim.x; asm volatile("" : "+s"(G2));
                pg8::Gemm g{H16, W1T, M, NP1, DM}; pg8::IdxOrder S; S.init(G2, bx2);
                pg8::EpiProj E{QA, QB, QI, KI, GA, WI, 1.0f};
                FRESH_TID(tid4); pg8::gemm_phase<pg8::EpiProj, pg8::IdxOrder, 0, false>(lds, g, S, E, tid4); }
        }
        SEAM(P + 1);

        if (IN(P + 2)) PH_REP(2) {
            PH_ENTER();
            const float* rel_bias = KA_IN(ka, 11);
            PH_REP(10) for (int u0 = bx; u0 < 768; u0 += G) {
                const int u = (u0 & 7) * 96 + (u0 >> 3);
                const int b = u / 192, rem = u - b * 192, g = rem >> 6, rem2 = rem & 63, hh = rem2 >> 4, xx = rem2 & 15;
                const int dil = g == 0 ? 1 : (g == 1 ? 4 : 16), nblk = 16 / dil, res = xx / nblk, blk = xx - res * nblk;
                __syncthreads();
                { LAS float* tabw = (LAS float*)(lds + att::OFF_TAB);
                  for (int i = tid; i < att::TABA_N; i += NTHREADS) { const int dist = att::TABA_DMAX - i;
                      tabw[i] = (dist >= 0 && dist <= 128) ? rel_bias[t5_bucket(dist * dil) * 20 + g * 4 + hh] * LOG2E : 0.f; } }
                att::UnitA U; const size_t base = ((size_t)b * SEQ + res) * WIDTH_A + g * 512 + hh * 128;
                U.pitch = (size_t)dil * WIDTH_A; U.opitch = U.pitch; U.q0 = 256 * blk;
                U.K = nullptr; U.Q = nullptr; U.K8 = (const unsigned char*)KA + base; U.Q8 = (const unsigned char*)QA + base + (size_t)U.q0 * U.pitch; U.V = VA + base; U.O = OA + base + (size_t)U.q0 * U.pitch;
                U.lse = LSE + ((size_t)b * SEQ + res + (size_t)U.q0 * dil) * 12 + g * 4 + hh; U.lse_pitch = dil * 12;
                U.t_lo = blk == 0 ? 0 : 4 * blk - 2; U.t_hi = 4 * blk + 4;
                att::attn_unit<0>(lds, U, nullptr, 0.f, tid);
            }
            __syncthreads();
            {
                LAS float* wT = (LAS float*)lds;
                float wnx[4]; h16x8 knx[4]; bool have_nx = false;
                auto i1_item = [&](auto tln_c, const int u, const int qs, const int kh, const int tl0, const int unext) {
                    constexpr int TLN = decltype(tln_c)::value;
                    int tid_u = tid; asm volatile("" : "+v"(tid_u));
                    const int lane_u = tid_u & 63, r32 = lane_u & 31, hi = lane_u >> 5;
                    const int b = u / 272; int rem = u - b * 272, i = 0;
                    { int p = 0; for (;;) { const int c = (i >> 1) + 1; if (rem < p + c) break; p += c; ++i; } rem -= p; }
                    const int j = rem;
                    float wpre[4]; h16x8 kpre[4];
                    if (have_nx) {
#pragma unroll
                        for (int e4 = 0; e4 < 4; ++e4) { wpre[e4] = wnx[e4]; kpre[e4] = knx[e4]; }
                    } else { const float* wg = WI + ((size_t)b * SEQ + 128 * i) * 16; const h16* kg = KI + ((size_t)b * SEQ + 256 * j) * 64;
#pragma unroll
                      for (int e4 = 0; e4 < 4; ++e4) { const int e = tid_u + NTHREADS * e4; wpre[e4] = wg[e]; kpre[e4] = *(const h16x8*)(kg + (size_t)(e >> 3) * 64 + (e & 7) * 8); } }
#define I1_PREFETCH() do { have_nx = unext >= 0; if (have_nx) { const int bn = unext / 272; int remn = unext - bn * 272, in_ = 0; { int p = 0; for (;;) { const int c = (in_ >> 1) + 1; if (remn < p + c) break; p += c; ++in_; } remn -= p; } \
                        const float* wg = WI + ((size_t)bn * SEQ + 128 * in_) * 16; const h16* kg = KI + ((size_t)bn * SEQ + 256 * remn) * 64; int tp_ = tid; asm volatile("" : "+v"(tp_)); \
                        _Pragma("unroll") for (int e4 = 0; e4 < 4; ++e4) { const int e = tp_ + NTHREADS * e4; wnx[e4] = wg[e]; knx[e4] = *(const h16x8*)(kg + (size_t)(e >> 3) * 64 + (e & 7) * 8); } } \
                        else { _Pragma("unroll") for (int e4 = 0; e4 < 4; ++e4) { wnx[e4] = 0.f; knx[e4] = (h16x8){0, 0, 0, 0, 0, 0, 0, 0}; } } } while (0)
                    __syncthreads();
#pragma unroll
                    for (int e4 = 0; e4 < 4; ++e4) { const int e = tid_u + NTHREADS * e4; wT[(e & 15) * 128 + (e >> 4)] = wpre[e4] * 0.03125f;
                        *(LAS h16x8*)(lds + 8192 + (e >> 3) * 144 + (e & 7) * 16) = kpre[e4]; }
                    __syncthreads();
                    if (2 * j + kh <= i) {
                    const size_t tok0 = (size_t)b * SEQ + 128 * i + 32 * qs;
                    const LAS unsigned char* kl = lds + 8192 + (128 * kh + 32 * tl0 + r32) * 144 + hi * 16;
                    f32x16 acc[TLN];
                    const char* qbase = (const char*)(QI + tok0 * 1024); const unsigned qoff = (unsigned)(r32 * 1024 + 8 * hi) * 2u;
                    h16x8 afA[4], afB[4];
                    h16x8 kf[TLN][4];
#pragma unroll
                    for (int tl = 0; tl < TLN; ++tl)
#pragma unroll
                        for (int ks = 0; ks < 4; ++ks) kf[tl][ks] = *(const LAS h16x8*)(kl + (32 * tl) * 144 + 32 * ks);
#define I1_LOAD(dst, h_) do { unsigned vo_ = qoff; const char* qb_ = qbase + (size_t)(128 * (h_)); asm volatile("" : "+v"(vo_), "+s"(qb_)); \
                        _Pragma("unroll") for (int ks = 0; ks < 4; ++ks) dst[ks] = *(const h16x8*)(qb_ + vo_ + 32 * ks); } while (0)
#define I1_HEAD(af, h_, FIRST) do { const float wq_ = wT[(h_) * 128 + 32 * qs + r32]; \
                        _Pragma("unroll") for (int tl = 0; tl < TLN; ++tl) { f32x16 d; \
                            _Pragma("unroll") for (int r = 0; r < 16; ++r) d[r] = 0.f; \
                            _Pragma("unroll") for (int ks = 0; ks < 4; ++ks) d = __builtin_amdgcn_mfma_f32_32x32x16_f16(kf[tl][ks], af[ks], d, 0, 0, 0); \
                            _Pragma("unroll") for (int r = 0; r < 16; ++r) acc[tl][r] = (FIRST) ? I1_RELU(d[r]) * wq_ : fmaf(I1_RELU(d[r]), wq_, acc[tl][r]); } } while (0)
                    I1_LOAD(afA, 0);
                    I1_LOAD(afB, 1);
                    I1_HEAD(afA, 0, true);
                    I1_LOAD(afA, 2);
                    I1_HEAD(afB, 1, false);
#pragma unroll 1
                    for (int h = 2; h < 16; h += 2) {
                        I1_LOAD(afB, h + 1);
                        I1_HEAD(afA, h, false);
                        if (h + 2 < 16) I1_LOAD(afA, h + 2);
                        I1_HEAD(afB, h + 1, false);
                    }
#undef I1_LOAD
#undef I1_HEAD
                    I1_PREFETCH();
                    const int Li = 128 * (i + 1);
                    int zs_ = 0; asm volatile("" : "+v"(zs_)); const int lane_s = (int)__builtin_amdgcn_mbcnt_hi(~0u, __builtin_amdgcn_mbcnt_lo(~0u, (unsigned)zs_)), r32s = lane_s & 31, his = lane_s >> 5;
                    unsigned short* sp = SC + ((size_t)b * 528 + (size_t)(i * (i + 1) / 2)) * 16384 + (size_t)(32 * qs + r32s) * Li + 256 * j + 128 * kh + 32 * tl0 + 8 * his;
#pragma unroll
                    for (int tl = 0; tl < TLN; ++tl)
#pragma unroll
                        for (int pg = 0; pg < 2; ++pg) { const int g = 2 * pg;
                            const unsigned a0 = pkh(acc[tl][4 * g], acc[tl][4 * g + 1]), a1 = pkh(acc[tl][4 * g + 2], acc[tl][4 * g + 3]), b0 = pkh(acc[tl][4 * g + 4], acc[tl][4 * g + 5]), b1 = pkh(acc[tl][4 * g + 6], acc[tl][4 * g + 7]);
                            const auto s0 = __builtin_amdgcn_permlane32_swap(a0, b0, false, false), s1 = __builtin_amdgcn_permlane32_swap(a1, b1, false, false);
                            *(u32x4*)(sp + 32 * tl + 16 * pg) = (u32x4){s0[0], s1[0], s0[1], s1[1]}; }
                    } else { I1_PREFETCH(); }
#undef I1_PREFETCH
                };
                PH_REP(11) { const int nfull = G == 256 ? 1024 : 1088;
                    const int uq = G == 256 ? (bx & 7) * 136 + 128 + (bx >> 5) : -1;
                    for (int u0 = bx; u0 < nfull; u0 += G) { const int un = u0 + G; i1_item(IC<4>{}, (u0 & 7) * 136 + (u0 >> 3), wave & 3, wave >> 2, 0, un < nfull ? (un & 7) * 136 + (un >> 3) : uq); }
                    if (G == 256) i1_item(IC<1>{}, uq, (bx >> 3) & 3, wave >> 2, wave & 3, -1); }
            }
        }
        SEAM(P + 2);

        if (IN(P + 3)) PH_REP(3) {
            PH_ENTER();
            PH_REP(12) for (int it = gw; it < M; it += NGW) {
                const int b = it >> 12, t0_ = it & 4095, t = t0_ < 2048 ? t0_ : 6143 - t0_, rw = (b << 12) + t, i = t >> 7, rr = t & 127, n = t + 1, nj = (n + 63) >> 6;
                const unsigned short* row = SC + ((size_t)b * 528 + (size_t)(i * (i + 1) / 2)) * 16384 + (size_t)rr * (128 * (i + 1));
                unsigned mlo = 0u, mhi = 0u;
#define TK_PUT(j, bl) do { const bool me_ = lane == (j); mlo = me_ ? (unsigned)(bl) : mlo; mhi = me_ ? (unsigned)((bl) >> 32) : mhi; asm volatile("" : "+v"(mlo), "+v"(mhi)); } while (0)
                if (n <= TOPK) {
#pragma unroll
                    for (int j = 0; j < 4; ++j) { const unsigned long long bl = __ballot(64 * j + lane < n); TK_PUT(j, bl); }
                } else {
                    unsigned uk[64];
#pragma unroll
                    for (int j = 0; j < 64; ++j) uk[j] = 0u;
#pragma unroll
                    for (int g8 = 0; g8 < 8; ++g8) if (8 * g8 < nj) {
#pragma unroll
                        for (int jj = 0; jj < 8; ++jj) { const int k = 64 * (8 * g8 + jj) + lane; uk[8 * g8 + jj] = (unsigned)row[k < n ? k : n - 1]; } }
#pragma unroll
                    for (int g8 = 0; g8 < 8; ++g8) if (8 * g8 < nj) {
#pragma unroll
                        for (int jj = 0; jj < 8; ++jj) { const int j = 8 * g8 + jj, k = 64 * j + lane;
                            unsigned bits = uk[j]; if (bits == 0x8000u) bits = 0u;
                            const unsigned key = (bits & 0x8000u) ? (~bits & 0xffffu) : (bits | 0x8000u); uk[j] = k < n ? key : 0u; } }
                    unsigned T = 0u; bool exact = false;
                    for (int bit = 15; bit >= 0; --bit) {
                        const unsigned cand = T | (1u << bit); int cl = 0;
#pragma unroll
                        for (int g8 = 0; g8 < 8; ++g8) if (8 * g8 < nj) {
#pragma unroll
                            for (int jj = 0; jj < 8; ++jj) cl += (uk[8 * g8 + jj] >= cand) ? 1 : 0; }
                        const int c = wave_sum_dpp(cl);
                        if (c >= TOPK) { T = cand; if (c == TOPK) { exact = true; break; } }
                    }
                    if (exact) {
#pragma unroll
                        for (int g8 = 0; g8 < 8; ++g8) if (8 * g8 < nj) {
#pragma unroll
                            for (int jj = 0; jj < 8; ++jj) { const unsigned long long bs = __ballot(uk[8 * g8 + jj] >= T); TK_PUT(8 * g8 + jj, bs); } }
                    } else {
                        int cgl = 0;
#pragma unroll
                        for (int g8 = 0; g8 < 8; ++g8) if (8 * g8 < nj) {
#pragma unroll
                            for (int jj = 0; jj < 8; ++jj) cgl += (uk[8 * g8 + jj] > T) ? 1 : 0; }
                        const int need = TOPK - wave_sum_dpp(cgl); int tb = 0;
#pragma unroll
                        for (int g8 = 0; g8 < 8; ++g8) if (8 * g8 < nj) {
#pragma unroll
                            for (int jj = 0; jj < 8; ++jj) { const int j = 8 * g8 + jj;
                                const bool eq = uk[j] == T; const unsigned long long be = __ballot(eq);
                                const int rank = tb + __builtin_amdgcn_mbcnt_hi((unsigned)(be >> 32), __builtin_amdgcn_mbcnt_lo((unsigned)be, 0u));
                                const bool sel = (uk[j] > T) || (eq && rank < need);
                                const unsigned long long bs = __ballot(sel); TK_PUT(j, bs);
                                tb += __popcll(be); } }
                    }
                }
#undef TK_PUT
                *(u32x2*)(MASK + (size_t)rw * 64 + lane) = (u32x2){mlo, mhi};
            }
            PH_REP(13) for (int rw0 = gw; rw0 < M; rw0 += 2 * NGW) {
                const int hh = lane >> 4, dd = (lane & 15) * 8;
                int rws[2]; rws[0] = rw0; rws[1] = (rw0 + NGW < M) ? rw0 + NGW : rw0;
                float lq[2][3]; u32x4 oq[2][3];
#pragma unroll
                for (int q = 0; q < 2; ++q) { const float* lp = LSE + (size_t)rws[q] * 12 + hh; lq[q][0] = lp[0]; lq[q][1] = lp[4]; lq[q][2] = lp[8];
                    const h16* op = OA + (size_t)rws[q] * WIDTH_A + hh * 128 + dd; oq[q][0] = *(const u32x4*)(op); oq[q][1] = *(const u32x4*)(op + 512); oq[q][2] = *(const u32x4*)(op + 1024); }
#pragma unroll
                for (int q = 0; q < 2; ++q) {
                    const float mx = fmaxf(lq[q][0], fmaxf(lq[q][1], lq[q][2]));
                    float w0 = __builtin_amdgcn_exp2f(lq[q][0] - mx), w1 = __builtin_amdgcn_exp2f(lq[q][1] - mx), w2 = __builtin_amdgcn_exp2f(lq[q][2] - mx);
                    const float inv = 1.0f / (w0 + w1 + w2); w0 *= inv; w1 *= inv; w2 *= inv;
                    f32x4 a0, a1, b0, b1, c0, c1;
                    pg8::unpack8h(oq[q][0], a0, a1); pg8::unpack8h(oq[q][1], b0, b1); pg8::unpack8h(oq[q][2], c0, c1);
                    const f32x4 y0 = a0 * w0 + b0 * w1 + c0 * w2, y1 = a1 * w0 + b1 * w1 + c1 * w2;
                    *(u32x2*)(YY8 + (size_t)rws[q] * 1536 + hh * 128 + dd) = (u32x2){pkf8(y0.x * 16.f, y0.y * 16.f, y0.z * 16.f, y0.w * 16.f), pkf8(y1.x * 16.f, y1.y * 16.f, y1.z * 16.f, y1.w * 16.f)};
                }
            }
        }
        SEAM(P + 3);

        if (IN(P + 4)) PH_REP(4) {
            PH_ENTER();
            const float* rel_bias = KA_IN(ka, 11);
            for (int pu = bx; pu < 256; pu += G) {
                const int xcd_ = pu & 7, slot_ = pu >> 3, bh = 8 * (slot_ >> 3) + xcd_, pr = slot_ & 7, b = bh >> 3, h = bh & 7;
                for (int pass = 0; pass < 2; ++pass) {
                    const int qb = pass == 0 ? 15 - pr : pr;
                    __syncthreads();
                    { LAS float* tabw = (LAS float*)(lds + att::OFF_TAB8);
                      for (int i = tid; i < att::TABB_N; i += NTHREADS) { const int dist = att::TABB_DMAX - i;
                          tabw[i] = dist >= 0 ? rel_bias[t5_bucket(dist) * 20 + 12 + h] * LOG2E : 0.f; } }
                    att::UnitA U; const size_t base = (size_t)b * SEQ * WIDTH_B + h * 128;
                    U.pitch = WIDTH_B; U.opitch = 1536; U.q0 = 256 * qb;
                    U.K = nullptr; U.Q = nullptr; U.K8 = (const unsigned char*)KB + base; U.Q8 = (const unsigned char*)QB + base + (size_t)U.q0 * WIDTH_B; U.V = nullptr; U.V8 = VT8 + (size_t)(b * 8 + h) * (64 * 8192); U.O = (h16*)(YY8 + ((size_t)b * SEQ + U.q0) * 1536 + 512 + h * 128);
                    U.lse = nullptr; U.lse_pitch = 0; U.t_lo = 0; U.t_hi = 4 * qb + 4;
                    att::attn_unit<1>(lds, U, MASK + (size_t)b * SEQ * 64, rel_bias[31 * 20 + 12 + h] * LOG2E, tid);
                }
            }
            __syncthreads();
        }
        SEAM(P + 4);

        if (IN(P + 5)) PH_REP(5) {
            PH_ENTER();
            pg8::Gemm g{(const h16*)YY8, (const h16*)WAB8, M, DM, 1536}; pg8::StaticOrder S; S.init(M, DM, G, bx); pg8::EpiMerge E{GA, GB, MG8};
            pg8::gemm_phase<pg8::EpiMerge, pg8::StaticOrder, 4, true>(lds, g, S, E, tid);
        }
        SEAM(P + 5);

        if (IN(P + 6)) PH_REP(6) {
            PH_ENTER();
            pg8::Gemm g{(const h16*)MG8, (const h16*)WO8, M, DM, DM}; pg8::StaticOrder S; S.init(M, DM, G, bx); pg8::EpiResid E{XS, XS, 1.0f / 1024.0f};
            pg8::gemm_phase<pg8::EpiResid, pg8::StaticOrder, 0, true>(lds, g, S, E, tid);
        }
        SEAM(P + 6);

        if (IN(P + 7)) PH_REP(7) {
            PH_ENTER();
            const float* g_ffn = KA_IN(ka, 9) + (size_t)layer * DM;
            rms_rows_h16<false>(XS, g_ffn, H16, nullptr, gw, NGW, lane);
        }
        SEAM(P + 7);

        if (IN(P + 8)) PH_REP(8) {
            PH_ENTER();
            pg8::Gemm g{H16, WGUT, M, NGU, DM}; pg8::StaticOrder S; S.init(M, NGU, G, bx); pg8::EpiSwiglu<F8_DOWN(layer)> E{HID};
            pg8::gemm_phase<pg8::EpiSwiglu<F8_DOWN(layer)>, pg8::StaticOrder>(lds, g, S, E, tid);
        }
        SEAM(P + 8);

        if (IN(P + 9)) PH_REP(9) {
            PH_ENTER();
            pg8::Gemm g{HID, WDT, M, DM, DFF}; pg8::StaticOrder S; S.init(M, DM, G, bx); pg8::EpiResid E{XS, layer + 1 < DEPTH ? XS : XF, F8_DOWN(layer) ? 1.0f / 512.0f : 1.0f};
            pg8::gemm_phase<pg8::EpiResid, pg8::StaticOrder, 0, F8_DOWN(layer)>(lds, g, S, E, tid);
        }
        SEAM(P + 9);
        }

    if (IN(20)) {
        PH_ENTER();
        const float* g_fin = KA_IN(ka, 10); float* outp = KA_OUT(ka); const h16* xf = XF;
        f32x4 ga[4], gb[4];
#pragma unroll
        for (int j = 0; j < 4; ++j) { ga[j] = *(const f32x4*)(g_fin + 8 * (lane + 64 * j)); gb[j] = *(const f32x4*)(g_fin + 8 * (lane + 64 * j) + 4); }
        for (int m0 = gw; m0 < M; m0 += 2 * NGW) {
            const int m1 = (m0 + NGW < M) ? m0 + NGW : m0;
            u32x4 r0[4], r1[4];
#pragma unroll
            for (int j = 0; j < 4; ++j) { r0[j] = *((const u32x4*)(xf + (size_t)m0 * DM) + lane + 64 * j); r1[j] = *((const u32x4*)(xf + (size_t)m1 * DM) + lane + 64 * j); }
            f32x4 va[4], vb[4], wa[4], wb[4]; float s0 = 0.f, s1 = 0.f;
#pragma unroll
            for (int j = 0; j < 4; ++j) { pg8::unpack8h(r0[j], va[j], vb[j]); pg8::unpack8h(r1[j], wa[j], wb[j]);
                s0 += (va[j].x * va[j].x + va[j].y * va[j].y) + (va[j].z * va[j].z + va[j].w * va[j].w) + (vb[j].x * vb[j].x + vb[j].y * vb[j].y) + (vb[j].z * vb[j].z + vb[j].w * vb[j].w);
                s1 += (wa[j].x * wa[j].x + wa[j].y * wa[j].y) + (wa[j].z * wa[j].z + wa[j].w * wa[j].w) + (wb[j].x * wb[j].x + wb[j].y * wb[j].y) + (wb[j].z * wb[j].z + wb[j].w * wb[j].w); }
            const float q0 = 1.0f / sqrtf(wave_sum(s0) * (1.0f / DM) + RMS_EPS), q1 = 1.0f / sqrtf(wave_sum(s1) * (1.0f / DM) + RMS_EPS);
            float* o0 = outp + (size_t)m0 * DM; float* o1 = outp + (size_t)m1 * DM;
#pragma unroll
            for (int j = 0; j < 4; ++j) { *(f32x4*)(o0 + 8 * (lane + 64 * j)) = va[j] * q0 * ga[j]; *(f32x4*)(o0 + 8 * (lane + 64 * j) + 4) = vb[j] * q0 * gb[j];
                                          *(f32x4*)(o1 + 8 * (lane + 64 * j)) = wa[j] * q1 * ga[j]; *(f32x4*)(o1 + 8 * (lane + 64 * j) + 4) = wb[j] * q1 * gb[j]; }
        }
    }
#undef IN
#undef SEAM
}

extern "C" void kernel_launch(void* const* d_in, const int* in_sizes, int n_in, void* d_out, int out_size, void* d_ws, size_t ws_size, hipStream_t stream) {
    static int grid = 0;
    if (grid == 0) {
        if (n_in != 12 || in_sizes[0] != M * DM || out_size != M * DM || ws_size < WS_END) {
            fprintf(stderr, "kernel_launch: unexpected shapes / workspace (n_in %d, in0 %d, out %d, ws %zu, need %zu); nothing launched\n", n_in, n_in > 0 ? in_sizes[0] : -1, out_size, ws_size, (size_t)WS_END);
            grid = -1; return; }
        int dev = 0, cus = 0, per_cu = 0;
        if (hipGetDevice(&dev) != hipSuccess || hipDeviceGetAttribute(&cus, hipDeviceAttributeMultiprocessorCount, dev) != hipSuccess) { grid = -1; return; }
        if (hipFuncSetAttribute((const void*)fwd_kernel, hipFuncAttributeMaxDynamicSharedMemorySize, LDS_BYTES) != hipSuccess) { fprintf(stderr, "kernel_launch: hipFuncSetAttribute failed\n"); grid = -1; return; }
        if (hipOccupancyMaxActiveBlocksPerMultiprocessor(&per_cu, (const void*)fwd_kernel, NTHREADS, LDS_BYTES) != hipSuccess || per_cu < 1)
            fprintf(stderr, "kernel_launch: note: occupancy query reports %d workgroups per CU\n", per_cu);
        (void)hipGetLastError();
        grid = cus;
    }
    if (grid < 0) return;
    if (hipMemsetAsync((char*)d_ws + WS_CTL, 0, CTL_ZERO_BYTES, stream) != hipSuccess) return;
    Args a{};
    for (int i = 0; i < 12; ++i) a.in[i] = (const float*)d_in[i];
    a.out = (float*)d_out; a.ws = (unsigned char*)d_ws;
#if MK_PER_PHASE_LAUNCH
    for (int p = 0; p <= 20; ++p) { a.ph_lo = p; a.ph_hi = p + 1; hipLaunchKernelGGL(fwd_kernel, dim3(grid), dim3(NTHREADS), LDS_BYTES, stream, a); }
#else
    a.ph_lo = 0; a.ph_hi = 21;
    hipLaunchKernelGGL(fwd_kernel, dim3(grid), dim3(NTHREADS), LDS_BYTES, stream, a);
#endif
    const hipError_t le = hipPeekAtLastError();
    if (le != hipSuccess) fprintf(stderr, "kernel_launch: launch failed: %s\n", hipGetErrorName(le));
}
```
